# Optimizing an MI355X kernel written in HIP

```python
import jax, jax.numpy as jnp
from jax import lax
import numpy as np

D_MODEL = 1024
BATCH = 8
SEQ = 4096
DEPTH = 1

POOL_GROUPS = 4
POOL_GROUP_DIM = 128
POOL_DIM = POOL_GROUPS * POOL_GROUP_DIM
POOL_WINDOWS = (2, 4, 8, 16)
DN_HEADS = 8
DN_HEAD_DIM = 128
DN_DIM = DN_HEADS * DN_HEAD_DIM
SHORT_CONV = 5
CHUNK = 64
FFN_DIM = 2816
FFN_CONV = 3
NORM_EPS = 1e-6
L2_EPS = 1e-6

IN_SIZES = (POOL_DIM, DN_DIM, DN_DIM, DN_DIM, DN_DIM,
            DN_HEADS, DN_HEADS, DN_HEADS, DN_HEADS, D_MODEL, D_MODEL)
IN_DIM = sum(IN_SIZES)
SPLIT_POINTS = tuple(int(s) for s in np.cumsum(IN_SIZES)[:-1])

kernel_name = "hybrid_pool_deltanet_convffn_encoder"


def rmsnorm(x, w):
    xf = x.astype(jnp.float32)
    y = xf * lax.rsqrt(jnp.mean(xf * xf, axis=-1, keepdims=True) + NORM_EPS)
    return (y * w.astype(jnp.float32)).astype(x.dtype)


def dwconv_centered(x, w, b=None):
    K = w.shape[0]
    S = x.shape[1]
    pad = K // 2
    xp = jnp.pad(x, ((0, 0), (pad, pad), (0, 0)))
    y = w[0] * xp[:, 0:S]
    for t in range(1, K):
        y = y + w[t] * xp[:, t:t + S]
    if b is not None:
        y = y + b
    return y


def multiscale_pool(p):
    B, S = p.shape[0], p.shape[1]
    pf = p.astype(jnp.float32).reshape(B, S, POOL_GROUPS, POOL_GROUP_DIM)
    c = jnp.concatenate([jnp.zeros((B, 1, POOL_GROUPS, POOL_GROUP_DIM), jnp.float32),
                         jnp.cumsum(pf, axis=1)], axis=1)
    pos = jnp.arange(S)
    outs = []
    for g, w in enumerate(POOL_WINDOWS):
        start = jnp.clip(pos - w // 2, 0, S)
        end = jnp.clip(pos + w - w // 2, 0, S)
        cg = c[:, :, g]
        wsum = jnp.take(cg, end, axis=1) - jnp.take(cg, start, axis=1)
        cnt = (end - start).astype(jnp.float32)[None, :, None]
        outs.append(wsum / cnt - pf[:, :, g])
    return jnp.stack(outs, axis=2)


def l2norm(t):
    return t * lax.rsqrt(jnp.sum(t * t, axis=-1, keepdims=True) + L2_EPS)


def gated_delta_rule(q, k, v, g, beta):
    B, S, H, dk = q.shape
    dv = v.shape[-1]
    N = S // CHUNK

    def chunks(t):
        t = jnp.swapaxes(t, 1, 2)
        return t.reshape((B, H, N, CHUNK) + t.shape[3:])

    q, k, v, g, beta = chunks(q), chunks(k), chunks(v), chunks(g), chunks(beta)
    G = jnp.cumsum(g, axis=-1)
    idx = jnp.arange(CHUNK)
    incl = idx[:, None] >= idx[None, :]
    strict = idx[:, None] > idx[None, :]
    diff = G[..., :, None] - G[..., None, :]
    decay = jnp.where(incl, jnp.exp(jnp.minimum(diff, 0.0)), 0.0)
    kb = k * beta[..., None]
    vb = v * beta[..., None]
    L = jnp.where(strict, jnp.einsum('bhnid,bhnjd->bhnij', kb, k) * decay, 0.0)
    eye = jnp.eye(CHUNK, dtype=L.dtype)
    rhs = jnp.concatenate([kb * jnp.exp(G)[..., None], vb], axis=-1)
    sol = lax.linalg.triangular_solve(L + eye, rhs, left_side=True, lower=True,
                                      unit_diagonal=True)
    w_c, u_c = sol[..., :dk], sol[..., dk:]
    attn = jnp.einsum('bhnid,bhnjd->bhnij', q, k) * decay
    qg = q * jnp.exp(G)[..., None]
    G_last = G[..., -1:]
    kd = k * jnp.exp(G_last - G)[..., None]
    gl = jnp.exp(G_last[..., 0])
    xs = (jnp.moveaxis(qg, 2, 0), jnp.moveaxis(attn, 2, 0), jnp.moveaxis(w_c, 2, 0),
          jnp.moveaxis(u_c, 2, 0), jnp.moveaxis(kd, 2, 0), jnp.moveaxis(gl, 2, 0))

    def step(state, inp):
        qg_n, attn_n, w_n, u_n, kd_n, gl_n = inp
        v_new = u_n - jnp.einsum('bhcd,bhde->bhce', w_n, state)
        o = (jnp.einsum('bhcd,bhde->bhce', qg_n, state)
             + jnp.einsum('bhij,bhje->bhie', attn_n, v_new))
        state = state * gl_n[..., None, None] + jnp.einsum('bhcd,bhce->bhde', kd_n, v_new)
        return state, o

    s0 = jnp.zeros((B, H, dk, dv), jnp.float32)
    _, o = lax.scan(step, s0, xs)
    o = jnp.moveaxis(o, 0, 2).reshape(B, H, S, dv)
    return jnp.swapaxes(o, 1, 2)


def setup_inputs(seed: int = 0) -> dict:
    key = jax.random.key(seed)
    ks = jax.random.split(key, 20)
    f32 = jnp.float32
    nrm = lambda k, shape, scale: jax.random.normal(k, shape, f32) * scale
    dt = jnp.exp(jax.random.uniform(ks[7], (DEPTH, 2, DN_HEADS), f32,
                                    minval=float(np.log(1e-3)), maxval=float(np.log(1e-1))))
    return {
        "x": nrm(ks[0], (BATCH, SEQ, D_MODEL), 1.0),
        "norm1_w": 1.0 + nrm(ks[1], (DEPTH, D_MODEL), 0.02),
        "w_in": nrm(ks[2], (DEPTH, D_MODEL, IN_DIM), D_MODEL ** -0.5),
        "pool_w": nrm(ks[3], (DEPTH, POOL_GROUPS, POOL_GROUP_DIM, POOL_GROUP_DIM), POOL_GROUP_DIM ** -0.5),
        "pool_scale": 1.0 + nrm(ks[4], (DEPTH, POOL_DIM), 0.02),
        "pool_out": nrm(ks[5], (DEPTH, POOL_DIM, D_MODEL), POOL_DIM ** -0.5),
        "qkv_conv_w": nrm(ks[6], (DEPTH, SHORT_CONV, 3 * DN_DIM), SHORT_CONV ** -0.5),
        "a_log": jnp.log(jax.random.uniform(ks[8], (DEPTH, 2, DN_HEADS), f32, minval=1.0, maxval=16.0)),
        "dt_bias": dt + jnp.log(-jnp.expm1(-dt)),
        "dn_norm_w": 1.0 + nrm(ks[9], (DEPTH, DN_HEAD_DIM), 0.02),
        "dn_out": nrm(ks[10], (DEPTH, DN_DIM, D_MODEL), DN_DIM ** -0.5),
        "w_o": nrm(ks[11], (DEPTH, D_MODEL, D_MODEL), D_MODEL ** -0.5),
        "norm2_w": 1.0 + nrm(ks[12], (DEPTH, D_MODEL), 0.02),
        "ffn_up": nrm(ks[13], (DEPTH, D_MODEL, 2 * FFN_DIM), D_MODEL ** -0.5),
        "ffn_conv_w": nrm(ks[14], (DEPTH, FFN_CONV, 2 * FFN_DIM), FFN_CONV ** -0.5),
        "ffn_conv_b": nrm(ks[15], (DEPTH, 2 * FFN_DIM), 0.02),
        "ffn_down": nrm(ks[16], (DEPTH, FFN_DIM, D_MODEL), FFN_DIM ** -0.5),
        "final_norm_w": 1.0 + nrm(ks[17], (D_MODEL,), 0.02),
    }


def reference(x, norm1_w, w_in, pool_w, pool_scale, pool_out, qkv_conv_w, a_log, dt_bias,
              dn_norm_w, dn_out, w_o, norm2_w, ffn_up, ffn_conv_w, ffn_conv_b, ffn_down,
              final_norm_w):
    B, S, _ = x.shape
    dt_x = x.dtype
    f32 = jnp.float32
    for l in range(DEPTH):
        h = rmsnorm(x, norm1_w[l])
        proj = h @ w_in[l]
        p, q, k, v, z, bf, bb, af, ab, g_pool, g_dn = jnp.split(proj, SPLIT_POINTS, axis=-1)

        pm = multiscale_pool(p)
        pm = jnp.einsum('bsgc,gcd->bsgd', pm, pool_w[l].astype(f32)).reshape(B, S, POOL_DIM)
        pm = (pm * pool_scale[l].astype(f32)).astype(dt_x)
        y_pool = pm @ pool_out[l]

        qkv = jax.nn.silu(dwconv_centered(jnp.concatenate([q, k, v], axis=-1), qkv_conv_w[l]))
        qc, kc, vc = jnp.split(qkv.astype(f32), 3, axis=-1)
        qc = l2norm(qc.reshape(B, S, DN_HEADS, DN_HEAD_DIM)) * (DN_HEAD_DIM ** -0.5)
        kc = l2norm(kc.reshape(B, S, DN_HEADS, DN_HEAD_DIM))
        vc = vc.reshape(B, S, DN_HEADS, DN_HEAD_DIM)
        a_l = a_log[l].astype(f32)
        dtb = dt_bias[l].astype(f32)
        beta_f = jax.nn.sigmoid(bf.astype(f32))
        beta_b = jax.nn.sigmoid(bb.astype(f32))
        g_f = -jnp.exp(a_l[0]) * jax.nn.softplus(af.astype(f32) + dtb[0])
        g_b = -jnp.exp(a_l[1]) * jax.nn.softplus(ab.astype(f32) + dtb[1])
        o_f = gated_delta_rule(qc, kc, vc, g_f, beta_f)
        flip = lambda t: jnp.flip(t, axis=1)
        o_b = flip(gated_delta_rule(flip(qc), flip(kc), flip(vc), flip(g_b), flip(beta_b)))
        o = o_f + o_b
        o = o * lax.rsqrt(jnp.mean(o * o, axis=-1, keepdims=True) + NORM_EPS)
        o = o * dn_norm_w[l].astype(f32) * jax.nn.silu(z.astype(f32).reshape(B, S, DN_HEADS, DN_HEAD_DIM))
        y_dn = o.reshape(B, S, DN_DIM).astype(dt_x) @ dn_out[l]

        merged = jax.nn.sigmoid(g_pool) * y_pool + jax.nn.sigmoid(g_dn) * y_dn
        x = x + merged @ w_o[l]

        h2 = rmsnorm(x, norm2_w[l])
        u = dwconv_centered(h2 @ ffn_up[l], ffn_conv_w[l], ffn_conv_b[l])
        gate, val = jnp.split(u, 2, axis=-1)
        x = x + (jax.nn.silu(gate) * val) @ ffn_down[l]
    return rmsnorm(x, final_norm_w)
```

```cpp
#include <hip/hip_runtime.h>
#include <hip/hip_cooperative_groups.h>
#include <stdint.h>
#include <stdio.h>
namespace cg = cooperative_groups;

#ifndef N_LAUNCH_MODE
#define N_LAUNCH_MODE 1
#endif

#ifndef DUP_MASK
#define DUP_MASK 0u
#endif
#ifndef DP_DUP
#define DP_DUP 0
#endif
typedef unsigned short u16;
typedef short bf16x8 __attribute__((ext_vector_type(8)));
typedef float f32x4 __attribute__((ext_vector_type(4)));
typedef unsigned u32x4 __attribute__((ext_vector_type(4)));
typedef unsigned u32x2 __attribute__((ext_vector_type(2)));
#define LAS __attribute__((address_space(3)))

constexpr int T = 32768, SEQ = 4096;
constexpr int NBLK = 256;
constexpr int NSTAGE = 4, CPS = 64 / NSTAGE;
constexpr size_t MB = (size_t)1 << 20;
constexpr size_t O_WIN = 0;
constexpr size_t O_UP = 14 * MB;
constexpr size_t O_DN = 25 * MB;
constexpr size_t O_BC = 31 * MB;
constexpr size_t O_WO = 34 * MB;
constexpr size_t O_GATES = 36 * MB;
constexpr size_t O_GL = 40 * MB;
constexpr size_t O_BAR = 40 * MB + 65536;
constexpr size_t O_SSQ = 40 * MB + 131072;
constexpr size_t O_HB = 42 * MB;
constexpr size_t O_QKV = 106 * MB;
constexpr size_t O_P = 298 * MB;
constexpr size_t O_PM = 330 * MB;
constexpr size_t O_OPS = 362 * MB;
constexpr size_t O_AC = 362 * MB;
constexpr size_t O_M = 298 * MB;
constexpr size_t O_U = 106 * MB;
constexpr size_t WS_NEED = 506 * MB;
constexpr int OPS_BYTES = 73728;
constexpr int LDS_BYTES = 143872;

struct Params {
  const float *x, *norm1_w, *w_in, *pool_w, *pool_scale, *pool_out, *qkv_conv_w, *a_log, *dt_bias, *dn_norm_w, *dn_out, *w_o, *norm2_w,
      *ffn_up, *ffn_conv_w, *ffn_conv_b, *ffn_down, *final_norm_w;
  float* out;
  unsigned char* ws;
  int ph_lo, ph_hi;
};

__device__ __forceinline__ unsigned pk2(float lo, float hi) {
  typedef float f2 __attribute__((ext_vector_type(2)));
  typedef __bf16 b2 __attribute__((ext_vector_type(2)));
  f2 v = {lo, hi};
  b2 b = __builtin_convertvector(v, b2);
  return __builtin_bit_cast(unsigned, b);
}
__device__ __forceinline__ float bflo(unsigned w) { return __uint_as_float(w << 16); }
__device__ __forceinline__ float bfhi(unsigned w) { return __uint_as_float(w & 0xffff0000u); }
__device__ __forceinline__ float bf1(u16 h) { return __uint_as_float(((unsigned)h) << 16); }
__device__ __forceinline__ u16 f2bf(float f) { return (u16)(pk2(f, 0.f) & 0xffffu); }
__device__ __forceinline__ float sigmoidf_(float x) { return __builtin_amdgcn_rcpf(1.f + __expf(-x)); }
__device__ __forceinline__ float siluf_(float x) { return x * __builtin_amdgcn_rcpf(1.f + __expf(-x)); }
__device__ __forceinline__ void unpack8(u32x4 w, float* f) {
  f[0] = bflo(w.x); f[1] = bfhi(w.x); f[2] = bflo(w.y); f[3] = bfhi(w.y);
  f[4] = bflo(w.z); f[5] = bfhi(w.z); f[6] = bflo(w.w); f[7] = bfhi(w.w);
}
__device__ __forceinline__ u32x4 pack8(const float* f) {
  u32x4 w; w.x = pk2(f[0], f[1]); w.y = pk2(f[2], f[3]); w.z = pk2(f[4], f[5]); w.w = pk2(f[6], f[7]); return w;
}
__device__ __forceinline__ int otid() { int t = threadIdx.x; asm volatile("" : "+v"(t)); return t; }
__device__ __forceinline__ int obid() { int b = blockIdx.x; asm volatile("" : "+s"(b)); return b; }
__device__ __forceinline__ int pos32(int x) { return (x & ~31) | (((x >> 2) & 3) << 3) | (((x >> 4) & 1) << 2) | (x & 3); }


#define XB_TMO      128
#define XB_XCNT(j)  (256  + 64 * (j))
#define XB_XSUB(j)  (1280 + 64 * (j))
#define XB_XGEN(j)  (2304 + 64 * (j))
#define XB_TOP      3328
#define XB_TOPGEN   3392
#define XCD_BAR_WORDS 3456
#define XB_SPIN_CAP (1u << 20)
__device__ __forceinline__ unsigned xb_ld(unsigned* p)              { return __hip_atomic_load(p, __ATOMIC_RELAXED, __HIP_MEMORY_SCOPE_AGENT); }
__device__ __forceinline__ unsigned xb_add(unsigned* p, unsigned v) { return __hip_atomic_fetch_add(p, v, __ATOMIC_RELAXED, __HIP_MEMORY_SCOPE_AGENT); }
__device__ __forceinline__ unsigned xb_xcc_id() { return (unsigned)__builtin_amdgcn_s_getreg((3 << 11) | 20) & 0xFu; }
#define XB_SPIN(cond, bar) do { unsigned _sp = 0; while (cond) { __builtin_amdgcn_s_sleep(1); \
    if ((++_sp & 255u) == 0u) { if (xb_ld(&(bar)[XB_TMO])) break; if (_sp > XB_SPIN_CAP) { atomicAdd(&(bar)[XB_TMO], 1u); break; } } } } while (0)
struct XcdBarrier { unsigned* bar; unsigned x; volatile LAS unsigned* st; };
__device__ __forceinline__ XcdBarrier xcd_barrier_post(unsigned* bar, volatile LAS unsigned* st) {
    XcdBarrier b; b.bar = bar; b.x = xb_xcc_id(); b.st = st;
    if (threadIdx.x == 0) (void)xb_add(&bar[XB_XCNT(b.x)], 1u);
    return b;
}
__device__ __forceinline__ void xcd_barrier_complete(unsigned* bar, unsigned x, unsigned& nloc, unsigned& nx) {
    const unsigned G = gridDim.x * gridDim.y * gridDim.z;
    unsigned sum, cnt, mine, sp = 0u;
    for (;;) {
        sum = 0u; cnt = 0u; mine = 0u;
#pragma unroll
        for (unsigned j = 0; j < 16; ++j) { const unsigned c = xb_ld(&bar[XB_XCNT(j)]); sum += c; cnt += (c > 0u) ? 1u : 0u; mine = (j == x) ? c : mine; }
        if (sum == G) break;
        __builtin_amdgcn_s_sleep(1);
        if ((++sp & 255u) == 0u) { if (xb_ld(&bar[XB_TMO])) break; if (sp > XB_SPIN_CAP) { atomicAdd(&bar[XB_TMO], 1u); break; } }
    }
    nloc = mine > 0u ? mine : 1u; nx = cnt > 0u ? cnt : 1u;
}
__device__ __forceinline__ void xcd_barrier(const XcdBarrier& b) {
    asm volatile("s_waitcnt vmcnt(0)" ::: "memory");
    __syncthreads();
    if (threadIdx.x == 0) {
        unsigned* bar = b.bar;
        __builtin_amdgcn_s_waitcnt(0);
        unsigned nloc = b.st[0], nx = b.st[1];
        if (nloc == 0u) { xcd_barrier_complete(bar, b.x, nloc, nx); b.st[0] = nloc; b.st[1] = nx; }
        const unsigned old = xb_add(&bar[XB_XSUB(b.x)], 1u);
        const unsigned gen = old / nloc;
        if (old + 1u == (gen + 1u) * nloc) {
            __builtin_amdgcn_fence(__ATOMIC_RELEASE, "agent");
            asm volatile("s_waitcnt vmcnt(0)" ::: "memory");
            const unsigned og = xb_add(&bar[XB_TOP], 1u);
            const unsigned tg = og / nx;
            if (og + 1u == (tg + 1u) * nx) xb_add(&bar[XB_TOPGEN], 1u);
            else XB_SPIN(xb_ld(&bar[XB_TOPGEN]) == tg, bar);
            __builtin_amdgcn_fence(__ATOMIC_ACQUIRE, "agent");
            xb_add(&bar[XB_XGEN(b.x)], 1u);
            asm volatile("s_waitcnt vmcnt(0)" ::: "memory");
        } else {
            XB_SPIN(xb_ld(&bar[XB_XGEN(b.x)]) == gen, bar);
            __builtin_amdgcn_fence(__ATOMIC_ACQUIRE, "agent");
            asm volatile("s_waitcnt vmcnt(0)" ::: "memory");
        }
    }
    __syncthreads();
}

constexpr int BM = 256, BK = 64, HALF = 128, HTB = HALF * BK * 2;
__device__ __forceinline__ int lds_byte(int r, int c) {
  int st = (r >> 4) * 2 + (c >> 5), rr = r & 15, cc = c & 31, ob = rr * 64 + cc * 2;
  return st * 1024 + (ob ^ (((ob >> 9) & 1) << 5));
}
__device__ __forceinline__ void stage_rc(int b, int& R, int& C) {
  int st = b / 1024, sb = b % 1024, swz = sb ^ (((sb >> 9) & 1) << 5);
  R = (st >> 1) * 16 + swz / 64; C = (st & 1) * 32 + (swz % 64) / 2;
}

#define G_SA(b, h) (((b) * 2 + (h)) * HTB)
#define G_SB(b, h) ((4 + (b) * 2 + (h)) * HTB)
#define G_STAGE(bufoff, gptr, voff) do { _Pragma("unroll") for (int _i = 0; _i < 2; ++_i) \
    __builtin_amdgcn_global_load_lds((const unsigned*)((const char*)(gptr) + (voff)[_i]), (LAS unsigned*)(lds + (bufoff) + tid * 16 + _i * 8192), 16, 0, 0); } while (0)
#define G_LDA(dst, b, h) do { _Pragma("unroll") for (int m = 0; m < 4; ++m) _Pragma("unroll") for (int k = 0; k < 2; ++k) \
    dst[m][k] = *(const LAS bf16x8*)(lds + G_SA(b, h) + aoff + m * 2048 + k * 1024); } while (0)
#define G_LDB(dst, b, h) do { _Pragma("unroll") for (int n = 0; n < 2; ++n) _Pragma("unroll") for (int k = 0; k < 2; ++k) \
    dst[n][k] = *(const LAS bf16x8*)(lds + G_SB(b, h) + boff + n * 2048 + k * 1024); } while (0)
#define G_MMA(ai, bj, At, Bt) do { __builtin_amdgcn_s_setprio(1); _Pragma("unroll") for (int m = 0; m < 4; ++m) _Pragma("unroll") for (int n = 0; n < 2; ++n) \
    _Pragma("unroll") for (int k = 0; k < 2; ++k) acc[ai][bj][m][n] = __builtin_amdgcn_mfma_f32_16x16x32_bf16(Bt[n][k], At[m][k], acc[ai][bj][m][n], 0, 0, 0); \
    __builtin_amdgcn_s_setprio(0); } while (0)
#define WAIT_V(n) asm volatile("s_waitcnt vmcnt(" #n ")" ::: "memory")
#define WAIT_L(n) asm volatile("s_waitcnt lgkmcnt(" #n ")" ::: "memory")
#define BAR __builtin_amdgcn_s_barrier()
#define SCHED __builtin_amdgcn_sched_barrier(0)

struct NoTileEpi { __device__ __forceinline__ void operator()(f32x4 (&)[2][2][4][2], int, int) const {} };
__device__ __forceinline__ int perm32r(int rho) { const int n = rho >> 4, i = rho & 15; return 8 * (i >> 2) + 4 * n + (i & 3); }
struct NoMid { __device__ __forceinline__ void operator()(f32x4 (&)[2][2][4][2], int, int) const {} };
struct NoRowEnd { __device__ __forceinline__ void operator()(int) const {} };
template <bool LDSEPI = false, bool PERM = false, class Pre, class Epi, class Tep = NoTileEpi, class Mid = NoMid, class RowEnd = NoRowEnd>
__device__ __forceinline__ void gemm_phase(LAS unsigned char* lds, const u16* A, int lda, const u16* Bt, int ldb, int M, int N, int K, int blk0, int nblk, const Pre& pre, const Epi& epi,
                                           int nM_ = 0, int mstride = BM, int moff = 0, const Tep& tep = Tep(), int nt_mid = -1, const Mid& mid = Mid(), const RowEnd& rowend = RowEnd()) {
  const int tid = otid(), wid = tid >> 6, lane = tid & 63, wr = wid >> 2, wc = wid & 3, fr = lane & 15, fq = lane >> 4;
  const int nt = K / BK;
  unsigned voffA[2], voffB[2];
#pragma unroll
  for (int i = 0; i < 2; ++i) { int R, C; stage_rc(tid * 16 + i * 8192, R, C); const int Rb = PERM ? ((R & ~31) + perm32r(R & 31)) : R;
    voffA[i] = (unsigned)(R * lda + C) * 2u; voffB[i] = (unsigned)(Rb * ldb + C) * 2u; }
  const int aoff = lds_byte(wr * 64 + fr, fq * 8), boff = lds_byte(wc * 32 + fr, fq * 8);
  const int nM = nM_ ? nM_ : M / BM, nN = N / BM, nwg = nM * nN;
  if (blk0 >= nwg) return;
  auto tile_rc = [&](int tile, int& brow, int& bcol) {
    int wgid = tile;
    { int q = nwg / 8, r = nwg % 8, xcd = wgid % 8, off = wgid / 8; wgid = (xcd < r ? xcd * (q + 1) : r * (q + 1) + (xcd - r) * q) + off; }
    const int nig = 8 * nN, gid = wgid / nig, fm = gid * 8, gsz = min(nM - fm, 8);
    const int pm = fm + ((wgid % nig) % gsz), pn = (wgid % nig) / gsz;
    brow = pm * mstride + moff; bcol = pn * BM;
  };
  const size_t hA = (size_t)HALF * lda, hB = (size_t)HALF * ldb;
  int tile = blk0, brow, bcol;
  tile_rc(tile, brow, bcol);
  const u16* Ab = A + (long)brow * lda;
  const u16* Bb = Bt + (size_t)bcol * ldb;
#define G_PROLOGUE do { G_STAGE(G_SB(0, 0), Bb, voffB); G_STAGE(G_SA(0, 0), Ab, voffA); \
  G_STAGE(G_SB(0, 1), Bb + hB, voffB); G_STAGE(G_SA(0, 1), Ab + hA, voffA); \
  if (wr == 1) BAR; \
  WAIT_V(4); BAR; \
  G_STAGE(G_SB(1, 0), Bb + BK, voffB); G_STAGE(G_SA(1, 0), Ab + BK, voffA); G_STAGE(G_SB(1, 1), Bb + hB + BK, voffB); \
  WAIT_V(6); BAR; } while (0)
  if (!LDSEPI) G_PROLOGUE;
  for (; tile < nwg; tile += nblk) {
    if (LDSEPI) G_PROLOGUE;
    const int ntile = tile + nblk < nwg ? tile + nblk : tile;
    int nbrow, nbcol;
    tile_rc(ntile, nbrow, nbcol);
    const u16* nAb = A + (long)nbrow * lda;
    const u16* nBb = Bt + (size_t)nbcol * ldb;
    f32x4 acc[2][2][4][2];
#pragma unroll
    for (int a = 0; a < 2; ++a)
#pragma unroll
      for (int b = 0; b < 2; ++b)
#pragma unroll
        for (int m = 0; m < 4; ++m)
#pragma unroll
          for (int n = 0; n < 2; ++n) acc[a][b][m][n] = (f32x4){0.f, 0.f, 0.f, 0.f};
    bf16x8 At[4][2], B0[2][2], B1[2][2];
    for (int t = 0; t < nt; t += 2) {
      if (t == nt_mid) mid(acc, brow, bcol);
      const bool lastp = t + 2 >= nt;
      const bool pf = !(LDSEPI && lastp);
      const u16* A2 = lastp ? nAb : Ab + (t + 2) * BK;
      const u16* B2 = lastp ? nBb : Bb + (t + 2) * BK;
      const u16* A1h = Ab + hA + (t + 1) * BK;
      G_LDB(B0, 0, 0); SCHED; G_LDA(At, 0, 0); G_STAGE(G_SA(1, 1), A1h, voffA);
      WAIT_L(8); BAR; WAIT_L(0); G_MMA(0, 0, At, B0); BAR; SCHED;
      G_LDB(B1, 0, 1); if (pf) G_STAGE(G_SB(0, 0), B2, voffB);
      BAR; WAIT_L(0); G_MMA(0, 1, At, B1); BAR;
      G_LDA(At, 0, 1); if (pf) G_STAGE(G_SA(0, 0), A2, voffA);
      BAR; WAIT_L(0); G_MMA(1, 0, At, B0); BAR; SCHED;
      if (pf) { G_STAGE(G_SB(0, 1), B2 + hB, voffB); WAIT_V(6); } else WAIT_V(0);
      BAR; G_MMA(1, 1, At, B1); BAR;
      G_LDB(B0, 1, 0); SCHED; G_LDA(At, 1, 0); if (pf) G_STAGE(G_SA(0, 1), A2 + hA, voffA);
      WAIT_L(8); BAR; WAIT_L(0); G_MMA(0, 0, At, B0); BAR; SCHED;
      G_LDB(B1, 1, 1); if (pf) G_STAGE(G_SB(1, 0), B2 + BK, voffB);
      BAR; WAIT_L(0); G_MMA(0, 1, At, B1); BAR;
      G_LDA(At, 1, 1); if (pf) G_STAGE(G_SA(1, 0), A2 + BK, voffA);
      BAR; WAIT_L(0); G_MMA(1, 0, At, B0); BAR; SCHED;
      if (pf) G_STAGE(G_SB(1, 1), B2 + hB + BK, voffB);
      WAIT_V(6); BAR; G_MMA(1, 1, At, B1); BAR;
    }
    if (LDSEPI) {
      if (wr == 0) BAR;
      tep(acc, brow, bcol);
    } else if constexpr (PERM) {
#pragma unroll
      for (int ai = 0; ai < 2; ++ai)
#pragma unroll
        for (int m = 0; m < 4; ++m)
#pragma unroll
          for (int bj = 0; bj < 2; ++bj)
            epi(brow + ai * HALF + wr * 64 + m * 16 + fr, bcol + bj * HALF + wc * 32 + fq * 8, acc[ai][bj][m][0], acc[ai][bj][m][1]);
    } else {
#pragma unroll
    for (int ai = 0; ai < 2; ++ai)
#pragma unroll
      for (int m2 = 0; m2 < 4; m2 += 2) {
        u32x4 pv[2][2][2];
#pragma unroll
        for (int mm = 0; mm < 2; ++mm)
#pragma unroll
          for (int bj = 0; bj < 2; ++bj)
#pragma unroll
            for (int n = 0; n < 2; ++n)
              pv[mm][bj][n] = pre(brow + ai * HALF + wr * 64 + (m2 + mm) * 16 + fr, bcol + bj * HALF + wc * 32 + n * 16 + fq * 4);
#pragma unroll
        for (int mm = 0; mm < 2; ++mm) {
#pragma unroll
          for (int bj = 0; bj < 2; ++bj)
#pragma unroll
            for (int n = 0; n < 2; ++n)
              epi(brow + ai * HALF + wr * 64 + (m2 + mm) * 16 + fr, bcol + bj * HALF + wc * 32 + n * 16 + fq * 4, acc[ai][bj][m2 + mm][n], pv[mm][bj][n]);
          rowend(brow + ai * HALF + wr * 64 + (m2 + mm) * 16 + fr);
        }
      }
    }
    if (LDSEPI) WAIT_V(0);
    Ab = nAb; Bb = nBb; brow = nbrow; bcol = nbcol;
  }
  if (!LDSEPI) { WAIT_V(0); if (wr == 0) BAR; }
}

template <class F>
__device__ __forceinline__ void transpose_w(const float* src, int Nsrc, u16* dst, int Ndst, int K, F nsrc_of, int gtid, int gsz, const float* kscale = nullptr, int ldd = 0) {
  if (ldd == 0) ldd = K;
  const int total = Ndst * (K / 32);
  for (int idx = gtid; idx < total; idx += gsz) {
    const int n = idx % Ndst, k32 = idx / Ndst;
    const int ns = nsrc_of(n);
    float v[32];
#pragma unroll
    for (int i = 0; i < 32; ++i) v[i] = ns >= 0 ? src[(size_t)(k32 * 32 + i) * Nsrc + ns] : 0.f;
    if (kscale) {
#pragma unroll
      for (int i = 0; i < 32; ++i) v[i] *= kscale[k32 * 32 + i];
    }
#pragma unroll
    for (int c = 0; c < 4; ++c) *(u32x4*)(dst + (size_t)n * ldd + k32 * 32 + c * 8) = pack8(v + c * 8);
  }
}

template <int CTRL> __device__ __forceinline__ float dpp_add(float v) {
  return v + __int_as_float(__builtin_amdgcn_update_dpp(0, __float_as_int(v), CTRL, 0xF, 0xF, true));
}
__device__ __forceinline__ float red16(float v) {
  v = dpp_add<0xB1>(v); v = dpp_add<0x4E>(v); v = dpp_add<0x141>(v); v = dpp_add<0x140>(v);
  return v;
}
__device__ __forceinline__ float wave_sum(float v) {
  v = red16(v); v += __shfl_xor(v, 16); v += __shfl_xor(v, 32);
  return v;
}

__device__ __forceinline__ void rmsnorm_rows_bf16(const float* in, const float* w, u16* out, int gtid, int gsz) {
  const int lane = gtid & 63, nw = gsz >> 6;
  for (int r0 = gtid >> 6; r0 < T; r0 += 2 * nw) {
    f32x4 v[2][4]; float ss[2] = {0.f, 0.f};
#pragma unroll
    for (int u = 0; u < 2; ++u) {
      const int r = min(r0 + u * nw, T - 1);
      const f32x4* xr = (const f32x4*)(in + (size_t)r * 1024);
#pragma unroll
      for (int i = 0; i < 4; ++i) v[u][i] = xr[i * 64 + lane];
    }
#pragma unroll
    for (int u = 0; u < 2; ++u) {
#pragma unroll
      for (int i = 0; i < 4; ++i) ss[u] += v[u][i][0] * v[u][i][0] + v[u][i][1] * v[u][i][1] + v[u][i][2] * v[u][i][2] + v[u][i][3] * v[u][i][3];
      ss[u] = wave_sum(ss[u]);
    }
#pragma unroll
    for (int u = 0; u < 2; ++u) {
      const int r = r0 + u * nw;
      if (r < T) {
        const float rs = rsqrtf(ss[u] * (1.f / 1024.f) + 1e-6f);
#pragma unroll
        for (int i = 0; i < 4; ++i) {
          const f32x4 ww = ((const f32x4*)w)[i * 64 + lane];
          u32x2 o; o.x = pk2(v[u][i][0] * rs * ww[0], v[u][i][1] * rs * ww[1]); o.y = pk2(v[u][i][2] * rs * ww[2], v[u][i][3] * rs * ww[3]);
          *(u32x2*)(out + (size_t)r * 1024 + (i * 64 + lane) * 4) = o;
        }
      }
    }
  }
}

__device__ __forceinline__ void phase_prep(const Params& p) {
  const int tid0 = otid();
  unsigned char* ws = p.ws;
  if (tid0 < 256) {
    rmsnorm_rows_bf16(p.x, p.norm1_w, (u16*)(ws + O_HB), obid() * 256 + tid0, NBLK * 256);
    for (int i = obid() * 256 + tid0; i < T; i += NBLK * 256) ((float*)(ws + O_SSQ))[i] = 0.f;
    return;
  }
  const int gtid = obid() * 256 + (tid0 - 256), gsz = NBLK * 256;
  transpose_w(p.w_in, 6688, (u16*)(ws + O_WIN), 6912, 1024, [](int n) {
    if (n < 3072) return 512 + n;
    if (n < 3584) return n - 3072;
    if (n < 3616) return 4608 + (n - 3584);
    if (n < 3840) return -1;
    const int m = n - 3840;
    return m < 1024 ? 3584 + m : 4640 + (m - 1024); }, gtid, gsz);
  transpose_w(p.ffn_up, 5632, (u16*)(ws + O_UP), 5632, 1024, [](int n) {
    const int pn = n >> 8, r = n & 255;
    return r < 128 ? pn * 128 + r : 2816 + pn * 128 + (r - 128); }, gtid, gsz, p.norm2_w);
  transpose_w(p.ffn_down, 1024, (u16*)(ws + O_DN), 1024, 2816, [](int n) { return n; }, gtid, gsz);
  transpose_w(p.dn_out, 1024, (u16*)(ws + O_BC) + 512, 1024, 1024, [](int n) { return n; }, gtid, gsz, nullptr, 1536);
  transpose_w(p.w_o, 1024, (u16*)(ws + O_WO), 1024, 1024, [](int n) { return n; }, gtid, gsz);
  for (int idx = gtid; idx < 1024 * 128; idx += gsz) {
    const int n = idx & 1023, k4 = idx >> 10, g = k4 >> 5, c0 = (k4 & 31) * 4;
    float a[4] = {0, 0, 0, 0};
#pragma unroll 2
    for (int d0 = 0; d0 < 128; d0 += 8) {
      float po[8];
#pragma unroll
      for (int dd = 0; dd < 8; ++dd) po[dd] = p.pool_out[(size_t)(g * 128 + d0 + dd) * 1024 + n];
      const f32x4 s0 = *(const f32x4*)(p.pool_scale + g * 128 + d0), s1 = *(const f32x4*)(p.pool_scale + g * 128 + d0 + 4);
      po[0] *= s0[0]; po[1] *= s0[1]; po[2] *= s0[2]; po[3] *= s0[3]; po[4] *= s1[0]; po[5] *= s1[1]; po[6] *= s1[2]; po[7] *= s1[3];
#pragma unroll
      for (int i = 0; i < 4; ++i) {
        const float* wr_ = p.pool_w + (size_t)((g * 128 + c0 + i) * 128) + d0;
        const f32x4 w0 = *(const f32x4*)wr_, w1 = *(const f32x4*)(wr_ + 4);
        a[i] += w0[0] * po[0] + w0[1] * po[1] + w0[2] * po[2] + w0[3] * po[3] + w1[0] * po[4] + w1[1] * po[5] + w1[2] * po[6] + w1[3] * po[7];
      }
    }
    u32x2 o; o.x = pk2(a[0], a[1]); o.y = pk2(a[2], a[3]);
    *(u32x2*)((u16*)(ws + O_BC) + (size_t)n * 1536 + k4 * 4) = o;
  }
}

constexpr int PQ = 0, PK = 17408, PV = 34816, PL = 52224, PS = 68608, PT = 69888, PHALF = 71936;

#define DP_IDS const int tid = otid(), dir = tid >> 8, ht = tid & 255, hw = (tid >> 6) & 3, lane = tid & 63, fr = lane & 15, fq = lane >> 4; \
  LAS unsigned char* L = lds + dir * PHALF; LAS float* Gs = (LAS float*)(L + PS); LAS float* Bs = Gs + 64; LAS float* EGs = Gs + 128; \
  LAS float* KDs = Gs + 192; LAS float* CWs = Gs + 256; (void)hw; (void)fr; (void)fq; (void)ht; (void)Bs; (void)EGs; (void)KDs; (void)CWs; (void)lane; \
  const int mstep = stage * CPS + j, n_orig = dir ? 63 - mstep : mstep, chain = bh * 2 + dir; (void)n_orig; \
  unsigned char* ops = p.ws + O_OPS + (size_t)(chain * CPS + j) * OPS_BYTES; (void)ops;
__device__ __forceinline__ void phase_dprep(const Params& p, LAS unsigned char* lds, int stage) {
  const u16* qkv = (const u16*)(p.ws + O_QKV);
  const float* gates = (const float*)(p.ws + O_GATES);
  float* glbuf = (float*)(p.ws + O_GL);
  u32x4 raw[12];
  float pg = 0.f, pbeta = 0.f;
  auto prefetch = [&](int item_) {
    const int bh = item_ / CPS, j = item_ % CPS, b = bh >> 3, h = bh & 7;
    const int tid = otid(), dir = tid >> 8, ht = tid & 255, hw = (tid >> 6) & 3, lane = tid & 63;
    const int mstep = stage * CPS + j, n_orig = dir ? 63 - mstep : mstep;
    const size_t tok0 = (size_t)b * SEQ + (size_t)n_orig * 64;
#pragma unroll
    for (int k = 0; k < 12; ++k) {
      const int idx = ht + k * 256, mat = idx >> 10, row = (idx >> 4) & 63, cgp = idx & 15;
      raw[k] = *(const u32x4*)(qkv + (tok0 + row) * 3072 + mat * 1024 + h * 128 + cgp * 8);
    }
    if (hw == 3) {
      const int row = dir ? 63 - lane : lane;
      const float* gp = gates + (tok0 + row) * 32;
      pg = gp[16 + dir * 8 + h]; pbeta = gp[dir * 8 + h];
    }
  };
  if (obid() < 64 * CPS) prefetch(obid());
  for (int item = obid(); item < 64 * CPS; item += NBLK) {
    const int bh = item / CPS, j = item % CPS;
    {
      DP_IDS
#pragma unroll
      for (int k = 0; k < 12; ++k) {
        const int idx = ht + k * 256, mat = idx >> 10, row = (idx >> 4) & 63, cgp = idx & 15, lrow = dir ? 63 - row : row;
        *(LAS u32x4*)(L + mat * 17408 + lrow * 272 + cgp * 16) = raw[k];
      }
      if (hw == 3) {
        float g = pg;
        const float beta = pbeta;
#pragma unroll
        for (int o = 1; o < 64; o <<= 1) { const float t = __shfl_up(g, o); if (lane >= o) g += t; }
        const float glast = __shfl(g, 63);
        Gs[lane] = g; Bs[lane] = beta; EGs[lane] = __expf(g); KDs[lane] = __expf(glast - g); CWs[lane] = beta * __expf(g);
        if (lane == 63) glbuf[chain * 64 + mstep] = __expf(g);
      }
    }
    __syncthreads();
    for (int rep = 0; rep < ((DP_DUP & 2) ? 2 : 1); ++rep) {
      DP_IDS
      bf16x8 ka[4], qa[4];
#pragma unroll
      for (int kb = 0; kb < 4; ++kb) {
        ka[kb] = *(const LAS bf16x8*)(L + PK + (hw * 16 + fr) * 272 + (kb * 32 + fq * 8) * 2);
        qa[kb] = *(const LAS bf16x8*)(L + PQ + (hw * 16 + fr) * 272 + (kb * 32 + fq * 8) * 2);
      }
      u16* attg = (u16*)(ops + 65536);
      LAS float* Ls = (LAS float*)(L + PL);
#pragma unroll
      for (int nt = 0; nt < 4; ++nt) {
        f32x4 kk = {0.f, 0.f, 0.f, 0.f}, qk = {0.f, 0.f, 0.f, 0.f};
#pragma unroll
        for (int kb = 0; kb < 4; ++kb) {
          const bf16x8 kbf = *(const LAS bf16x8*)(L + PK + (nt * 16 + fr) * 272 + (kb * 32 + fq * 8) * 2);
          kk = __builtin_amdgcn_mfma_f32_16x16x32_bf16(ka[kb], kbf, kk, 0, 0, 0);
          qk = __builtin_amdgcn_mfma_f32_16x16x32_bf16(kbf, qa[kb], qk, 0, 0, 0);
        }
        const int jj = nt * 16 + fr;
        const float gj = Gs[jj];
#pragma unroll
        for (int r = 0; r < 4; ++r) {
          const int ii = hw * 16 + fq * 4 + r;
          const float dec = __expf(fminf(Gs[ii] - gj, 0.f));
          Ls[ii * 64 + jj] = ii > jj ? Bs[ii] * kk[r] * dec : 0.f;
        }
        {
          const int ia = hw * 16 + fr, j0 = nt * 16 + fq * 4;
          const float gi = Gs[ia];
          f32x4 av;
#pragma unroll
          for (int r = 0; r < 4; ++r) av[r] = ia >= j0 + r ? qk[r] * __expf(fminf(gi - Gs[j0 + r], 0.f)) : 0.f;
          u32x2 o; o.x = pk2(av[0], av[1]); o.y = pk2(av[2], av[3]);
          *(u32x2*)(attg + ia * 64 + pos32(j0)) = o;
        }
      }
      asm volatile("s_waitcnt lgkmcnt(0)" ::: "memory");
      {
        const LAS float* Ld = Ls + (hw * 16) * 64 + hw * 16;
        float t[16];
#pragma unroll
        for (int i = 0; i < 16; ++i) {
          float a = (i == fr) ? 1.f : 0.f;
#pragma unroll
          for (int j4 = 0; j4 < (i + 3) / 4; ++j4) {
            const f32x4 l = *(const LAS f32x4*)(Ld + i * 64 + j4 * 4);
#pragma unroll
            for (int jj = 0; jj < 4; ++jj) if (j4 * 4 + jj < i) a -= l[jj] * t[j4 * 4 + jj];
          }
          t[i] = a;
        }
        if (fq == 0) {
          LAS u16* Tb = (LAS u16*)(L + PT) + hw * 256 + fr;
#pragma unroll
          for (int i = 0; i < 16; ++i) Tb[i * 16] = f2bf(i == fr ? 0.f : t[i]);
        }
      }
    }
    __syncthreads();
    if (item + NBLK < 64 * CPS) prefetch(item + NBLK);
    {
      DP_IDS
      {
        const int c = ht >> 2, kb = ht & 3;
        const float eg = EGs[c];
        float in[32], out[32];
#pragma unroll
        for (int v = 0; v < 4; ++v) { const u32x4 raw = *(const LAS u32x4*)(L + PQ + c * 272 + (kb * 32 + v * 8) * 2); unpack8(raw, in + v * 8); }
#pragma unroll
        for (int x = 0; x < 32; ++x) out[pos32(x)] = in[x] * eg;
#pragma unroll
        for (int v = 0; v < 4; ++v) *(u32x4*)(ops + 16384 + c * 256 + kb * 64 + v * 16) = pack8(out + v * 8);
      }
      __builtin_amdgcn_sched_barrier(0);
      {
        const int d = ht >> 1, cb = ht & 1;
        float out[32];
#pragma unroll
        for (int x = 0; x < 32; ++x) { const int c = cb * 32 + x; out[pos32(x)] = bf1(*(const LAS u16*)(L + PK + c * 272 + d * 2)) * KDs[c]; }
#pragma unroll
        for (int v = 0; v < 4; ++v) *(u32x4*)(ops + 32768 + d * 128 + cb * 64 + v * 16) = pack8(out + v * 8);
      }
      __builtin_amdgcn_sched_barrier(0);
      typedef short s16x4 __attribute__((ext_vector_type(4)));
      const LAS float* Ls = (const LAS float*)(L + PL);
      s16x4 Lf[6], Tf[4];
      {
        int n = 0;
#pragma unroll
        for (int I = 1; I < 4; ++I)
#pragma unroll
          for (int J = 0; J < I; ++J) {
            const f32x4 l = *(const LAS f32x4*)(Ls + (16 * I + fr) * 64 + 16 * J + 4 * fq);
            u32x2 pk; pk.x = pk2(l[0], l[1]); pk.y = pk2(l[2], l[3]);
            Lf[n++] = __builtin_bit_cast(s16x4, pk);
          }
#pragma unroll
        for (int I = 0; I < 4; ++I) Tf[I] = *(const LAS s16x4*)(L + PT + ((16 * I + fr) * 16 + 4 * fq) * 2);
      }
      const bool isw = hw < 2;
      const LAS float* cf = isw ? CWs : Bs;
      unsigned wpk[32];
#pragma unroll
      for (int k = 0; k < 32; ++k) wpk[k] = 0u;
#pragma unroll
      for (int tt = 0; tt < 4; ++tt) {
        const int col = ((hw & 1) * 4 + tt) * 16 + fr;
        const LAS unsigned char* src = L + (isw ? PK : PV) + col * 2;
        s16x4 Xb[4];
#pragma unroll
        for (int I = 0; I < 4; ++I) {
          f32x4 acc = {0.f, 0.f, 0.f, 0.f};
#pragma unroll
          for (int J = 0; J < I; ++J) acc = __builtin_amdgcn_mfma_f32_16x16x16bf16_1k(Lf[I * (I - 1) / 2 + J], Xb[J], acc, 0, 0, 0);
          const f32x4 cfi = *(const LAS f32x4*)(cf + 16 * I + 4 * fq);
          f32x4 y;
#pragma unroll
          for (int r = 0; r < 4; ++r) y[r] = bf1(*(const LAS u16*)(src + (16 * I + 4 * fq + r) * 272)) * cfi[r] - acc[r];
          u32x2 yp; yp.x = pk2(y[0], y[1]); yp.y = pk2(y[2], y[3]);
          const f32x4 x = __builtin_amdgcn_mfma_f32_16x16x16bf16_1k(Tf[I], __builtin_bit_cast(s16x4, yp), y, 0, 0, 0);
          u32x2 xp; xp.x = pk2(x[0], x[1]); xp.y = pk2(x[2], x[3]);
          Xb[I] = __builtin_bit_cast(s16x4, xp);
          if (isw) { wpk[tt * 8 + I * 2] = xp.x; wpk[tt * 8 + I * 2 + 1] = xp.y; }
          else *(u32x2*)(ops + 49152 + col * 128 + (16 * I + 4 * fq) * 2) = xp;
        }
      }
      __syncthreads();
      if (isw) {
#pragma unroll
        for (int tt = 0; tt < 4; ++tt) {
          const int d = (hw * 4 + tt) * 16 + fr;
          LAS unsigned char* wst = L + PQ + pos32(d) * 2;
#pragma unroll
          for (int I = 0; I < 4; ++I)
#pragma unroll
            for (int r = 0; r < 4; ++r) {
              const unsigned wv = wpk[tt * 8 + I * 2 + (r >> 1)];
              *(LAS u16*)(wst + (16 * I + 4 * fq + r) * 256) = (u16)((r & 1) ? (wv >> 16) : (wv & 0xffffu));
            }
        }
      }
      __syncthreads();
#pragma unroll
      for (int v = 0; v < 4; ++v) { const int idx = ht + v * 256; *(u32x4*)(ops + idx * 16) = *(const LAS u32x4*)(L + PQ + idx * 16); }
    }
    __syncthreads();
  }
}

constexpr int SW = 0, SQ = 17408, SK = 34816, SA_ = 53248, SBUF = 62464;

__device__ __forceinline__ void scan_load(const unsigned char* ops, u32x4 (&r)[7], int tid) {
#pragma unroll
  for (int i = 0; i < 6; ++i) r[i] = *(const u32x4*)(ops + (size_t)(i * 512 + tid) * 16);
  r[6] = *(const u32x4*)(ops + 65536 + (size_t)tid * 16);
}
__device__ __forceinline__ void scan_store(LAS unsigned char* buf, const u32x4 (&r)[7], int tid) {
#pragma unroll
  for (int i = 0; i < 6; ++i) {
    const int idx = i * 512 + tid;
    int off;
    if (idx < 2048) { const int m = idx >> 10, e = idx & 1023; off = m * 17408 + (e >> 4) * 272 + (e & 15) * 16; }
    else { const int e = idx - 2048; off = SK + (e >> 3) * 144 + (e & 7) * 16; }
    *(LAS u32x4*)(buf + off) = r[i];
  }
  *(LAS u32x4*)(buf + SA_ + (tid >> 3) * 144 + (tid & 7) * 16) = r[6];
}

__device__ __forceinline__ void phase_scan(const Params& p, LAS unsigned char* lds, int stage, bool save) {
  const int bid = obid();
  if (bid >= 256) return;
  const int chain = (bid >> 4) * 8 + (bid & 7), eh = (bid >> 3) & 1;
  const int tid = otid(), wv = tid >> 6, lane = tid & 63, fr = lane & 15, fq = lane >> 4;
  const bool comp = wv < 4;
  const int w = eh * 4 + (wv & 3);
  const int bh = chain >> 1, dir = chain & 1, b = bh >> 3, h = bh & 7;
  const unsigned char* opsb = p.ws + O_OPS + (size_t)chain * CPS * OPS_BYTES;
  const float* glbuf = (const float*)(p.ws + O_GL) + chain * 64;
  float* sst = (float*)(p.ws + O_PM) + (size_t)chain * 16384 + w * 2048 + lane;
  u16* og = (u16*)p.out + (size_t)dir * T * 1024;
  f32x4 S[8];
#pragma unroll
  for (int dt = 0; dt < 8; ++dt)
#pragma unroll
    for (int r = 0; r < 4; ++r) S[dt][r] = stage == 0 ? 0.f : sst[(dt * 4 + r) * 64];
  u32x4 stgA[14], stgB[14];
  const int lt = tid - 256;
  auto ld_ops = [&](const unsigned char* o_, u32x4 (&stg)[14]) {
    if (!comp) {
#pragma unroll
      for (int i = 0; i < 12; ++i) stg[i] = *(const u32x4*)(o_ + (size_t)(i * 256 + lt) * 16);
#pragma unroll
      for (int i = 0; i < 2; ++i) stg[12 + i] = *(const u32x4*)(o_ + 65536 + (size_t)(i * 256 + lt) * 16);
    }
  };
  auto st_ops = [&](LAS unsigned char* buf, const u32x4 (&stg)[14]) {
    if (!comp) {
#pragma unroll
      for (int i = 0; i < 12; ++i) {
        const int idx = i * 256 + lt;
        int off;
        if (idx < 2048) { const int m = idx >> 10, e = idx & 1023; off = m * 17408 + (e >> 4) * 272 + (e & 15) * 16; }
        else { const int e = idx - 2048; off = SK + (e >> 3) * 144 + (e & 7) * 16; }
        *(LAS u32x4*)(buf + off) = stg[i];
      }
#pragma unroll
      for (int i = 0; i < 2; ++i) { const int idx = i * 256 + lt; *(LAS u32x4*)(buf + SA_ + (idx >> 3) * 144 + (idx & 7) * 16) = stg[12 + i]; }
    }
  };
  u32x2 unx[4];
  float gln = glbuf[stage * CPS];
#pragma unroll
  for (int mt = 0; mt < 4; ++mt) unx[mt] = *(const u32x2*)(opsb + 49152 + (w * 16 + fr) * 128 + (mt * 16 + fq * 4) * 2);
  ld_ops(opsb, stgA);
  st_ops(lds, stgA);
  ld_ops(opsb + OPS_BYTES, stgA);
  __syncthreads();
  if (!comp) {
    for (int j = 0; j < CPS; j += 2) {
      if (j + 2 < CPS) ld_ops(opsb + (size_t)(j + 2) * OPS_BYTES, stgB);
      st_ops(lds + SBUF, stgA);
      __syncthreads();
      if (j + 3 < CPS) ld_ops(opsb + (size_t)(j + 3) * OPS_BYTES, stgA);
      if (j + 2 < CPS) st_ops(lds, stgB);
      __syncthreads();
    }
    return;
  }
  for (int j = 0; j < CPS; ++j) {
    LAS unsigned char* cur = lds + (j & 1) * SBUF;
    const unsigned char* ops = opsb + (size_t)j * OPS_BYTES;
    const int mstep = stage * CPS + j;
    {
    const float gl = gln;
    u32x2 uraw[4];
#pragma unroll
    for (int mt = 0; mt < 4; ++mt) uraw[mt] = unx[mt];
    if (j + 1 < CPS) {
      gln = glbuf[mstep + 1];
#pragma unroll
      for (int mt = 0; mt < 4; ++mt) unx[mt] = *(const u32x2*)(ops + OPS_BYTES + 49152 + (w * 16 + fr) * 128 + (mt * 16 + fq * 4) * 2);
    }
    bf16x8 Sb[4];
#pragma unroll
    for (int kb = 0; kb < 4; ++kb) {
      u32x4 t; t.x = pk2(S[2 * kb][0], S[2 * kb][1]); t.y = pk2(S[2 * kb][2], S[2 * kb][3]); t.z = pk2(S[2 * kb + 1][0], S[2 * kb + 1][1]); t.w = pk2(S[2 * kb + 1][2], S[2 * kb + 1][3]);
      Sb[kb] = __builtin_bit_cast(bf16x8, t);
    }
    f32x4 X[4], O[4];
#pragma unroll
    for (int mt = 0; mt < 4; ++mt) {
      f32x4 ws_ = {0.f, 0.f, 0.f, 0.f}, o = {0.f, 0.f, 0.f, 0.f};
#pragma unroll
      for (int kb = 0; kb < 4; ++kb) {
        const bf16x8 wa = *(const LAS bf16x8*)(cur + SW + (mt * 16 + fr) * 272 + (kb * 32 + fq * 8) * 2);
        const bf16x8 qa = *(const LAS bf16x8*)(cur + SQ + (mt * 16 + fr) * 272 + (kb * 32 + fq * 8) * 2);
        ws_ = __builtin_amdgcn_mfma_f32_16x16x32_bf16(wa, Sb[kb], ws_, 0, 0, 0);
        o = __builtin_amdgcn_mfma_f32_16x16x32_bf16(Sb[kb], qa, o, 0, 0, 0);
      }
      X[mt][0] = bflo(uraw[mt].x) - ws_[0]; X[mt][1] = bfhi(uraw[mt].x) - ws_[1]; X[mt][2] = bflo(uraw[mt].y) - ws_[2]; X[mt][3] = bfhi(uraw[mt].y) - ws_[3];
      O[mt] = o;
    }
    bf16x8 Xb[2];
#pragma unroll
    for (int kb = 0; kb < 2; ++kb) {
      u32x4 t; t.x = pk2(X[2 * kb][0], X[2 * kb][1]); t.y = pk2(X[2 * kb][2], X[2 * kb][3]); t.z = pk2(X[2 * kb + 1][0], X[2 * kb + 1][1]); t.w = pk2(X[2 * kb + 1][2], X[2 * kb + 1][3]);
      Xb[kb] = __builtin_bit_cast(bf16x8, t);
    }
#pragma unroll
    for (int mt = 0; mt < 4; ++mt)
#pragma unroll
      for (int kb = 0; kb < 2; ++kb) {
        const bf16x8 aa = *(const LAS bf16x8*)(cur + SA_ + (mt * 16 + fr) * 144 + (kb * 32 + fq * 8) * 2);
        O[mt] = __builtin_amdgcn_mfma_f32_16x16x32_bf16(Xb[kb], aa, O[mt], 0, 0, 0);
      }
#pragma unroll
    for (int dt = 0; dt < 8; ++dt) {
      f32x4 s = S[dt] * gl;
#pragma unroll
      for (int kb = 0; kb < 2; ++kb) {
        const bf16x8 ka = *(const LAS bf16x8*)(cur + SK + (dt * 16 + fr) * 144 + (kb * 32 + fq * 8) * 2);
        s = __builtin_amdgcn_mfma_f32_16x16x32_bf16(ka, Xb[kb], s, 0, 0, 0);
      }
      S[dt] = s;
    }
    const int n_orig = dir ? 63 - mstep : mstep;
#pragma unroll
    for (int mt = 0; mt < 4; ++mt) {
      const int c = mt * 16 + fr, row = dir ? 63 - c : c;
      u32x2 o; o.x = pk2(O[mt][0], O[mt][1]); o.y = pk2(O[mt][2], O[mt][3]);
      *(u32x2*)(og + ((size_t)b * SEQ + n_orig * 64 + row) * 1024 + h * 128 + w * 16 + fq * 4) = o;
    }
    }
    __syncthreads();
  }
  if (save) {
#pragma unroll
    for (int dt = 0; dt < 8; ++dt)
#pragma unroll
      for (int r = 0; r < 4; ++r) sst[(dt * 4 + r) * 64] = S[dt][r];
  }
}

template <int W>
__device__ __forceinline__ void pool_pm_task(const u16* P, u16* PMo, int tok, int c8) {
  const int pos = tok & (SEQ - 1);
  const int st = pos - W / 2;
  const u16* base = P + (size_t)(tok - pos) * 512 + c8 * 8;
  u32x4 raw[W];
#pragma unroll
  for (int k = 0; k < W; ++k) { const int q = min(max(st + k, 0), SEQ - 1); raw[k] = *(const u32x4*)(base + (size_t)q * 512); }
  float s[8] = {0, 0, 0, 0, 0, 0, 0, 0}, me[8];
  int cnt = 0;
#pragma unroll
  for (int k = 0; k < W; ++k) {
    const int q = st + k;
    float f[8]; unpack8(raw[k], f);
    if (q >= 0 && q < SEQ) {
      ++cnt;
#pragma unroll
      for (int i = 0; i < 8; ++i) s[i] += f[i];
    }
    if (k == W / 2) {
#pragma unroll
      for (int i = 0; i < 8; ++i) me[i] = f[i];
    }
  }
  const float inv = 1.f / (float)cnt;
#pragma unroll
  for (int i = 0; i < 8; ++i) s[i] = s[i] * inv - me[i];
  *(u32x4*)(PMo + (size_t)tok * 1536 + c8 * 8) = pack8(s);
}
__device__ __forceinline__ void phase_pool_pm(const Params& p) {
  const u16* P = (const u16*)(p.ws + O_P);
  u16* PMo = (u16*)(p.ws + O_AC);
  const int gtid = obid() * 512 + otid(), gsz = NBLK * 512;
  for (int idx = gtid; idx < T * 64; idx += gsz) {
    const int wv = idx >> 6, lane = idx & 63, g = wv & 3, tok = (wv >> 2) * 4 + (lane >> 4), c8 = g * 16 + (lane & 15);
    if (g == 0) pool_pm_task<2>(P, PMo, tok, c8);
    else if (g == 1) pool_pm_task<4>(P, PMo, tok, c8);
    else if (g == 2) pool_pm_task<8>(P, PMo, tok, c8);
    else pool_pm_task<16>(P, PMo, tok, c8);
  }
}

__device__ __forceinline__ void phase_onorm(const Params& p) {
  const u16* of = (const u16*)p.out;
  const u16* ob = of + (size_t)T * 1024;
  const u16* zg = (const u16*)(p.ws + O_QKV);
  u16* on = (u16*)(p.ws + O_AC) + 512;
  const int gtid = obid() * 512 + otid(), gsz = NBLK * 512;
  for (int idx0 = gtid; idx0 < T * 128; idx0 += 4 * gsz) {
    u32x4 ra[4], rb[4], rz[4];
#pragma unroll
    for (int u = 0; u < 4; ++u) {
      const int idx = min(idx0 + u * gsz, T * 128 - 1), tok = idx >> 7, c8 = idx & 127;
      ra[u] = *(const u32x4*)(of + (size_t)tok * 1024 + c8 * 8);
      rb[u] = *(const u32x4*)(ob + (size_t)tok * 1024 + c8 * 8);
      rz[u] = *(const u32x4*)(zg + (size_t)tok * 3072 + c8 * 8);
    }
#pragma unroll
    for (int u = 0; u < 4; ++u) {
    const int idx = idx0 + u * gsz;
    if (idx >= T * 128) break;
    const int tok = idx >> 7, c8 = idx & 127;
    float a[8], bb[8], z[8];
    unpack8(ra[u], a);
    unpack8(rb[u], bb);
    unpack8(rz[u], z);
    float ss = 0.f;
#pragma unroll
    for (int i = 0; i < 8; ++i) { a[i] += bb[i]; ss += a[i] * a[i]; }
    ss = red16(ss);
    const float rs = rsqrtf(ss * (1.f / 128.f) + 1e-6f);
    const float* nw = p.dn_norm_w + (c8 & 15) * 8;
#pragma unroll
    for (int i = 0; i < 8; ++i) a[i] = a[i] * rs * nw[i] * siluf_(z[i]);
    *(u32x4*)(on + (size_t)tok * 1536 + c8 * 8) = pack8(a);
    }
  }
}

__device__ __forceinline__ void phase_final_norm(const Params& p) {
  const int gtid = obid() * 512 + otid(), gsz = NBLK * 512, lane = gtid & 63, nw = gsz >> 6;
  for (int r0 = gtid >> 6; r0 < T; r0 += 2 * nw) {
    f32x4 v[2][4]; float ss[2] = {0.f, 0.f};
#pragma unroll
    for (int u = 0; u < 2; ++u) {
      const int r = min(r0 + u * nw, T - 1);
      const f32x4* xr = (const f32x4*)(p.out + (size_t)r * 1024);
#pragma unroll
      for (int i = 0; i < 4; ++i) v[u][i] = xr[i * 64 + lane];
    }
#pragma unroll
    for (int u = 0; u < 2; ++u) {
#pragma unroll
      for (int i = 0; i < 4; ++i) ss[u] += v[u][i][0] * v[u][i][0] + v[u][i][1] * v[u][i][1] + v[u][i][2] * v[u][i][2] + v[u][i][3] * v[u][i][3];
      ss[u] = wave_sum(ss[u]);
    }
#pragma unroll
    for (int u = 0; u < 2; ++u) {
      const int r = r0 + u * nw;
      if (r < T) {
        const float rs = rsqrtf(ss[u] * (1.f / 1024.f) + 1e-6f);
        f32x4* xr = (f32x4*)(p.out + (size_t)r * 1024);
#pragma unroll
        for (int i = 0; i < 4; ++i) { const f32x4 ww = ((const f32x4*)p.final_norm_w)[i * 64 + lane]; xr[i * 64 + lane] = v[u][i] * rs * ww; }
      }
    }
  }
}

__device__ __forceinline__ u32x2 pk4(f32x4 v) { u32x2 o; o.x = pk2(v[0], v[1]); o.y = pk2(v[2], v[3]); return o; }

__device__ __forceinline__ void run_phase(const Params& p, LAS unsigned char* lds, int ph, bool last_rep) {
  unsigned char* ws = p.ws;
  const int bid = obid(), nb = NBLK;
  if (ph == 0) { phase_prep(p); return; }
  if (ph == 1) {
    u16* qkv = (u16*)(ws + O_QKV); u16* pp = (u16*)(ws + O_P); float* gates = (float*)(ws + O_GATES);
    const float* a_log = p.a_log; const float* dtb = p.dt_bias; const float* cw = p.qkv_conv_w;
    auto tep = [=](f32x4 (&acc)[2][2][4][2], int brow, int bcol) {
      const int tid = otid(), wid = tid >> 6, lane = tid & 63, wr = wid >> 2, wc = wid & 3, fr = lane & 15, fq = lane >> 4;
      if (bcol >= 3072) {
#pragma unroll
        for (int ai = 0; ai < 2; ++ai)
#pragma unroll
          for (int m = 0; m < 4; ++m) {
            const int r = ai * HALF + wr * 64 + m * 16 + fr, g = brow + r;
            if (r >= 2 && r < 254 && g < T) {
#pragma unroll
              for (int bj = 0; bj < 2; ++bj)
#pragma unroll
                for (int n = 0; n < 2; ++n) {
                  const int col = bcol + bj * HALF + wc * 32 + n * 16 + fq * 4;
                  const f32x4 v = acc[ai][bj][m][n];
                  if (col < 3584) *(u32x2*)(pp + (size_t)g * 512 + (col - 3072)) = pk4(v);
                  else if (col < 3616) {
                    const int c0 = col - 3584;
                    f32x4 o;
#pragma unroll
                    for (int i = 0; i < 4; ++i) {
                      const int c = c0 + i;
                      if (c < 16) o[i] = sigmoidf_(v[i]);
                      else { const int k = c - 16; const float xx = v[i] + dtb[k]; const float ee = __expf(-fabsf(xx)); const float sp = fmaxf(xx, 0.f) + (ee < 1e-3f ? ee * (1.f - 0.5f * ee) : __logf(1.f + ee)); o[i] = -__expf(a_log[k]) * sp; }
                    }
                    *(f32x4*)(gates + (size_t)g * 32 + c0) = o;
                  }
                }
            }
          }
        return;
      }
#pragma unroll
      for (int ai = 0; ai < 2; ++ai)
#pragma unroll
        for (int m = 0; m < 4; ++m) {
          const int r = ai * HALF + wr * 64 + m * 16 + fr;
#pragma unroll
          for (int bj = 0; bj < 2; ++bj)
#pragma unroll
            for (int n = 0; n < 2; ++n) {
              const int c = (bj * HALF + wc * 32 + n * 16 + fq * 4) >> 2;
              *(LAS u32x2*)(lds + r * 512 + ((c ^ ((r & 15) << 2)) << 3)) = pk4(acc[ai][bj][m][n]);
            }
        }
      __syncthreads();
      const int c8 = lane & 31, rsel = lane >> 5;
      const int ch = bcol + c8 * 8;
      const bool donorm = bcol < 2048;
      const float osc = bcol < 1024 ? 0.08838834764831845f : 1.f;
      float w5[5][8];
#pragma unroll
      for (int t = 0; t < 5; ++t) {
        const f32x4 a = *(const f32x4*)(cw + t * 3072 + ch), bq = *(const f32x4*)(cw + t * 3072 + ch + 4);
        w5[t][0] = a[0]; w5[t][1] = a[1]; w5[t][2] = a[2]; w5[t][3] = a[3]; w5[t][4] = bq[0]; w5[t][5] = bq[1]; w5[t][6] = bq[2]; w5[t][7] = bq[3];
      }
      auto ldrow = [&](int r, float* f) {
        const u32x4 a = *(const LAS u32x4*)(lds + r * 512 + (((2 * c8) ^ ((r & 15) << 2)) << 3));
        unpack8(a, f);
      };
      const int r0 = 2 + wid * 32 + rsel * 16;
      float xw[5][8];
      ldrow(r0 - 2, xw[1]); ldrow(r0 - 1, xw[2]); ldrow(r0, xw[3]); ldrow(min(r0 + 1, 255), xw[4]);
#pragma unroll 2
      for (int k = 0; k < 16; ++k) {
        const int r = r0 + k;
#pragma unroll
        for (int t = 0; t < 4; ++t)
#pragma unroll
          for (int c = 0; c < 8; ++c) xw[t][c] = xw[t + 1][c];
        ldrow(min(r + 2, 255), xw[4]);
        const int g = brow + r, pos = g & (SEQ - 1);
        const bool t0 = pos >= 2, t1 = pos >= 1, t3 = pos < SEQ - 1, t4 = pos < SEQ - 2;
        float y[8], ss = 0.f;
#pragma unroll
        for (int c = 0; c < 8; ++c) {
          float v = w5[2][c] * xw[2][c];
          v += t0 ? w5[0][c] * xw[0][c] : 0.f; v += t1 ? w5[1][c] * xw[1][c] : 0.f;
          v += t3 ? w5[3][c] * xw[3][c] : 0.f; v += t4 ? w5[4][c] * xw[4][c] : 0.f;
          v = siluf_(v); y[c] = v; ss += v * v;
        }
        float sc = 1.f;
        if (donorm) { ss = red16(ss); sc = rsqrtf(ss + 1e-6f) * osc; }
#pragma unroll
        for (int c = 0; c < 8; ++c) y[c] *= sc;
        if (r < 254 && g < T) *(u32x4*)(qkv + (size_t)g * 3072 + ch) = pack8(y);
      }
      __syncthreads();
    };
    gemm_phase<true, false>(lds, (const u16*)(ws + O_HB), 1024, (const u16*)(ws + O_WIN), 1024, T, 3840, 1024, bid, nb,
                     [](int, int) { return (u32x4){0u, 0u, 0u, 0u}; }, [](int, int, f32x4, u32x4) {}, 131, 252, -2, tep);
    return;
  }
  if (ph >= 2 && ph < 2 + 2 * NSTAGE) {
    const int s = (ph - 2) >> 1;
    if ((ph - 2) & 1) phase_scan(p, lds, s, last_rep); else phase_dprep(p, lds, s);
    return;
  }
  const int q = ph - (2 + 2 * NSTAGE);
  if (q == 0) {
    phase_pool_pm(p);
    u16* zg = (u16*)(ws + O_QKV);
    gemm_phase<false, true>(lds, (const u16*)(ws + O_HB), 1024, (const u16*)(ws + O_WIN) + (size_t)3840 * 1024, 1024, T, 3072, 1024, bid, nb,
      [](int, int) { return (u32x4){0u, 0u, 0u, 0u}; }, [=](int row, int col0, f32x4 v0, f32x4 v1) {
      if (col0 >= 1024) {
#pragma unroll
        for (int i = 0; i < 4; ++i) { v0[i] = sigmoidf_(v0[i]); v1[i] = sigmoidf_(v1[i]); }
      }
      u32x4 o; o.x = pk2(v0[0], v0[1]); o.y = pk2(v0[2], v0[3]); o.z = pk2(v1[0], v1[1]); o.w = pk2(v1[2], v1[3]);
      *(u32x4*)(zg + (size_t)row * 3072 + col0) = o; });
    return;
  }
  if (q == 1) { phase_onorm(p); return; }
  if (q == 2) {
    const u16* zg = (const u16*)(ws + O_QKV); u16* mg = (u16*)(ws + O_M);
    auto mid = [=](f32x4 (&acc)[2][2][4][2], int brow, int bcol) {
      const int tid = otid(), wid = tid >> 6, lane = tid & 63, wr = wid >> 2, wc = wid & 3, fr = lane & 15, fq = lane >> 4;
#pragma unroll
      for (int ai = 0; ai < 2; ++ai)
#pragma unroll
        for (int m2 = 0; m2 < 4; m2 += 2) {
          u32x2 gp[2][2][2], gd[2][2][2];
#pragma unroll
          for (int mm = 0; mm < 2; ++mm)
#pragma unroll
            for (int bj = 0; bj < 2; ++bj)
#pragma unroll
              for (int n = 0; n < 2; ++n) {
                const u16* zr = zg + (size_t)(brow + ai * HALF + wr * 64 + (m2 + mm) * 16 + fr) * 3072 + bcol + bj * HALF + wc * 32 + n * 16 + fq * 4;
                gp[mm][bj][n] = *(const u32x2*)(zr + 1024); gd[mm][bj][n] = *(const u32x2*)(zr + 2048);
              }
#pragma unroll
          for (int mm = 0; mm < 2; ++mm)
#pragma unroll
            for (int bj = 0; bj < 2; ++bj)
#pragma unroll
              for (int n = 0; n < 2; ++n) {
                const u32x2 a = gp[mm][bj][n], d = gd[mm][bj][n];
                f32x4& v = acc[ai][bj][m2 + mm][n];
                v[0] *= bflo(a.x) * __builtin_amdgcn_rcpf(fmaxf(bflo(d.x), 1e-30f)); v[1] *= bfhi(a.x) * __builtin_amdgcn_rcpf(fmaxf(bfhi(d.x), 1e-30f));
                v[2] *= bflo(a.y) * __builtin_amdgcn_rcpf(fmaxf(bflo(d.y), 1e-30f)); v[3] *= bfhi(a.y) * __builtin_amdgcn_rcpf(fmaxf(bfhi(d.y), 1e-30f));
              }
        }
    };
    gemm_phase<false, false>(lds, (const u16*)(ws + O_AC), 1536, (const u16*)(ws + O_BC), 1536, T, 1024, 1536, bid, nb,
      [=](int row, int col) { const u32x2 g = *(const u32x2*)(zg + (size_t)row * 3072 + 2048 + col); return (u32x4){g.x, g.y, 0u, 0u}; },
      [=](int row, int col, f32x4 v, u32x4 pv) {
      v[0] *= bflo(pv.x); v[1] *= bfhi(pv.x); v[2] *= bflo(pv.y); v[3] *= bfhi(pv.y);
      *(u32x2*)(mg + (size_t)row * 1024 + col) = pk4(v); }, 0, BM, 0, NoTileEpi(), 8, mid);
    return;
  }
  if (q == 3) {
    const float* x = p.x; u16* x1b = (u16*)(ws + O_HB); float* ssq = (float*)(ws + O_SSQ);
    float ssacc = 0.f;
    gemm_phase(lds, (const u16*)(ws + O_M), 1024, (const u16*)(ws + O_WO), 1024, T, 1024, 1024, bid, nb,
      [=](int row, int col) { return *(const u32x4*)(x + (size_t)row * 1024 + col); },
      [=, &ssacc](int row, int col, f32x4 v, u32x4 pv) {
      const f32x4 r = __builtin_bit_cast(f32x4, pv) + v;
      *(u32x2*)(x1b + (size_t)row * 1024 + col) = pk4(r);
      ssacc += r[0] * r[0] + r[1] * r[1] + r[2] * r[2] + r[3] * r[3]; },
      0, BM, 0, NoTileEpi(), -1, NoMid(),
      [=, &ssacc](int row) {
      float ss = ssacc; ssacc = 0.f;
      ss += __shfl_xor(ss, 16); ss += __shfl_xor(ss, 32);
      if ((otid() & 48) == 0) atomicAdd(ssq + row, ss); });
    return;
  }
  if (q == 4) {
    u16* GV = (u16*)(ws + O_U);
    const float* cw = p.ffn_conv_w; const float* cb = p.ffn_conv_b; const float* ssq = (const float*)(ws + O_SSQ);
    auto tep = [=](f32x4 (&acc)[2][2][4][2], int brow, int bcol) {
      const int tid = otid(), wid = tid >> 6, lane = tid & 63, wr = wid >> 2, wc = wid & 3, fr = lane & 15, fq = lane >> 4;
#pragma unroll
      for (int ai = 0; ai < 2; ++ai)
#pragma unroll
        for (int m = 0; m < 4; ++m) {
          const int r = ai * HALF + wr * 64 + m * 16 + fr;
          const float rs = rsqrtf(ssq[min(max(brow + r, 0), T - 1)] * (1.f / 1024.f) + 1e-6f);
#pragma unroll
          for (int bj = 0; bj < 2; ++bj)
#pragma unroll
            for (int n = 0; n < 2; ++n) {
              const int c = (bj * HALF + wc * 32 + n * 16 + fq * 4) >> 2;
              *(LAS u32x2*)(lds + r * 512 + ((c ^ ((r & 15) << 2)) << 3)) = pk4(acc[ai][bj][m][n] * rs);
            }
        }
      __syncthreads();
      const int c4 = tid & 31, rr = tid >> 5, pn = bcol >> 8;
      const int gch = pn * 128 + c4 * 4, vch = 2816 + gch;
      f32x4 wg[3], wv[3];
#pragma unroll
      for (int t = 0; t < 3; ++t) { wg[t] = *(const f32x4*)(cw + t * 5632 + gch); wv[t] = *(const f32x4*)(cw + t * 5632 + vch); }
      const f32x4 bg = *(const f32x4*)(cb + gch), bv = *(const f32x4*)(cb + vch);
      auto ldrow = [&](int r, f32x4& g, f32x4& v) {
        const int sw = (r & 15) << 2;
        const u32x2 a = *(const LAS u32x2*)(lds + r * 512 + ((c4 ^ sw) << 3));
        const u32x2 b = *(const LAS u32x2*)(lds + r * 512 + (((32 + c4) ^ sw) << 3));
        g = (f32x4){bflo(a.x), bfhi(a.x), bflo(a.y), bfhi(a.y)}; v = (f32x4){bflo(b.x), bfhi(b.x), bflo(b.y), bfhi(b.y)};
      };
      const int r0 = 1 + rr * 16;
      f32x4 gp, vp, gc, vc, gn, vn;
      ldrow(r0 - 1, gp, vp); ldrow(r0, gc, vc);
#pragma unroll
      for (int k = 0; k < 16; ++k) {
        const int r = r0 + k;
        if (r <= 254) {
          ldrow(r + 1, gn, vn);
          const int g = brow + r, pos = g & (SEQ - 1);
          if (g < T) {
            f32x4 ga = bg + wg[1] * gc, va = bv + wv[1] * vc;
            if (pos != 0) { ga += wg[0] * gp; va += wv[0] * vp; }
            if (pos != SEQ - 1) { ga += wg[2] * gn; va += wv[2] * vn; }
            f32x4 o; o[0] = siluf_(ga[0]) * va[0]; o[1] = siluf_(ga[1]) * va[1]; o[2] = siluf_(ga[2]) * va[2]; o[3] = siluf_(ga[3]) * va[3];
            *(u32x2*)(GV + (size_t)g * 2816 + gch) = pk4(o);
          }
          gp = gc; vp = vc; gc = gn; vc = vn;
        }
      }
      __syncthreads();
    };
    gemm_phase<true, false>(lds, (const u16*)(ws + O_HB), 1024, (const u16*)(ws + O_UP), 1024, T, 5632, 1024, bid, nb,
                     [](int, int) { return (u32x4){0u, 0u, 0u, 0u}; }, [](int, int, f32x4, u32x4) {}, 130, 254, -1, tep);
    return;
  }
  if (q == 5) {
    float* out = p.out; const u16* x1b = (const u16*)(ws + O_HB);
    gemm_phase(lds, (const u16*)(ws + O_U), 2816, (const u16*)(ws + O_DN), 2816, T, 1024, 2816, bid, nb,
      [=](int row, int col) { const u32x2 a = *(const u32x2*)(x1b + (size_t)row * 1024 + col); return (u32x4){a.x, a.y, 0u, 0u}; },
      [=](int row, int col, f32x4 v, u32x4 pv) {
        v[0] += bflo(pv.x); v[1] += bfhi(pv.x); v[2] += bflo(pv.y); v[3] += bfhi(pv.y);
        *(f32x4*)(out + (size_t)row * 1024 + col) = v; });
    return;
  }
  if (q == 6) phase_final_norm(p);
}
constexpr int NPHASE = 2 + 2 * NSTAGE + 7;

__global__ void __launch_bounds__(512) mega(Params p) {
  extern __shared__ __attribute__((aligned(16))) unsigned char smem[];
  LAS unsigned char* lds = (LAS unsigned char*)smem;
  cg::grid_group grid = cg::this_grid();
  __shared__ uint4 xb_words;
  if (threadIdx.x == 0) xb_words = make_uint4(0u, 0u, 0u, 0u);
  __syncthreads();
  (void)xcd_barrier_post((unsigned*)(p.ws + O_BAR), (volatile LAS unsigned*)&xb_words);
  for (int ph = p.ph_lo; ph < p.ph_hi; ++ph) {
    const int reps = ((DUP_MASK >> ph) & 1u) ? 2 : 1;
    for (int r = 0; r < reps; ++r) {
      if (ph > p.ph_lo || r > 0) {
        if (ph == NPHASE - 2 && r == 0) grid.sync();
        else { XcdBarrier xb; size_t zb = 0; asm volatile("" : "+s"(zb)); xb.bar = (unsigned*)(p.ws + O_BAR + zb); xb.x = xb_xcc_id(); xb.st = (volatile LAS unsigned*)&xb_words; xcd_barrier(xb); }
      }
      Params q = p;
      size_t zoff = 0;
      asm volatile("" : "+s"(zoff));
      q.ws = p.ws + zoff; q.out = (float*)((unsigned char*)p.out + zoff);
      run_phase(q, lds, ph, r == reps - 1);
    }
  }
}

extern "C" void kernel_launch(void* const* d_in, const int* in_sizes, int n_in, void* d_out, int out_size, void* d_ws, size_t ws_size, hipStream_t stream) {
  static int grid_blocks = 0;
  if (!grid_blocks) {
    if (ws_size < WS_NEED || n_in != 18) { fprintf(stderr, "kernel_launch: need %zu bytes of workspace, got %zu (n_in %d)\n", WS_NEED, ws_size, n_in); grid_blocks = -1; return; }
    int dev = 0, cus = 0, per_cu = 0;
    hipGetDevice(&dev);
    hipDeviceGetAttribute(&cus, hipDeviceAttributeMultiprocessorCount, dev);
    hipFuncSetAttribute((const void*)mega, hipFuncAttributeMaxDynamicSharedMemorySize, LDS_BYTES);
    hipOccupancyMaxActiveBlocksPerMultiprocessor(&per_cu, (const void*)mega, 512, LDS_BYTES);
    if (cus < 256) { fprintf(stderr, "kernel_launch: built for a 256-CU device (got %d)\n", cus); grid_blocks = -1; return; }
    if (per_cu < 1) { fprintf(stderr, "kernel_launch: occupancy query says %d blocks per CU\n", per_cu); grid_blocks = -1; return; }
    grid_blocks = NBLK;
    (void)hipGetLastError();
  }
  if (grid_blocks < 0) return;
  Params p{};
  const float** pp = (const float**)&p;
  for (int i = 0; i < 18; ++i) pp[i] = (const float*)d_in[i];
  p.out = (float*)d_out; p.ws = (unsigned char*)d_ws;
  (void)hipMemsetAsync((unsigned char*)d_ws + O_BAR, 0, XCD_BAR_WORDS * 4, stream);
#if N_LAUNCH_MODE == 1
  p.ph_lo = 0; p.ph_hi = NPHASE;
  void* args[] = {&p};
  hipError_t e = hipLaunchCooperativeKernel((const void*)mega, dim3(grid_blocks), dim3(512), args, LDS_BYTES, stream);
  if (e != hipSuccess) fprintf(stderr, "cooperative launch failed: %s (grid %d)\n", hipGetErrorString(e), grid_blocks);
#else
  for (int ph = 0; ph < NPHASE; ++ph) {
    p.ph_lo = ph; p.ph_hi = ph + 1;
    hipLaunchKernelGGL(mega, dim3(grid_blocks), dim3(512), LDS_BYTES, stream, p);
  }
#endif
}
```

```cpp
#include <hip/hip_runtime.h>
#include <hip/hip_cooperative_groups.h>
#include <stdint.h>
#include <stdio.h>
namespace cg = cooperative_groups;

#ifndef N_LAUNCH_MODE
#define N_LAUNCH_MODE 1
#endif

#ifndef DUP_MASK
#define DUP_MASK 0u
#endif
#ifndef DP_DUP
#define DP_DUP 0
#endif
typedef unsigned short u16;
typedef short bf16x8 __attribute__((ext_vector_type(8)));
typedef float f32x4 __attribute__((ext_vector_type(4)));
typedef unsigned u32x4 __attribute__((ext_vector_type(4)));
typedef unsigned u32x2 __attribute__((ext_vector_type(2)));
#define LAS __attribute__((address_space(3)))

constexpr int T = 32768, SEQ = 4096;
constexpr int NBLK = 256;
constexpr int NSTAGE = 4, CPS = 64 / NSTAGE;
constexpr size_t MB = (size_t)1 << 20;
constexpr size_t O_WIN = 0;
constexpr size_t O_UP = 14 * MB;
constexpr size_t O_DN = 25 * MB;
constexpr size_t O_BC = 31 * MB;
constexpr size_t O_WO = 34 * MB;
constexpr size_t O_GATES = 36 * MB;
constexpr size_t O_GL = 40 * MB;
constexpr size_t O_BAR = 40 * MB + 65536;
constexpr size_t O_SSQ = 40 * MB + 131072;
constexpr size_t O_HB = 42 * MB;
constexpr size_t O_QKV = 106 * MB;
constexpr size_t O_P = 298 * MB;
constexpr size_t O_PM = 330 * MB;
constexpr size_t O_OPS = 362 * MB;
constexpr size_t O_AC = 362 * MB;
constexpr size_t O_M = 298 * MB;
constexpr size_t O_U = 106 * MB;
constexpr size_t WS_NEED = 506 * MB;
constexpr int OPS_BYTES = 73728;
constexpr int LDS_BYTES = 143872;

struct Params {
  const float *x, *norm1_w, *w_in, *pool_w, *pool_scale, *pool_out, *qkv_conv_w, *a_log, *dt_bias, *dn_norm_w, *dn_out, *w_o, *norm2_w,
      *ffn_up, *ffn_conv_w, *ffn_conv_b, *ffn_down, *final_norm_w;
  float* out;
  unsigned char* ws;
  int ph_lo, ph_hi;
};

__device__ __forceinline__ unsigned pk2(float lo, float hi) {
  typedef float f2 __attribute__((ext_vector_type(2)));
  typedef __bf16 b2 __attribute__((ext_vector_type(2)));
  f2 v = {lo, hi};
  b2 b = __builtin_convertvector(v, b2);
  return __builtin_bit_cast(unsigned, b);
}
__device__ __forceinline__ float bflo(unsigned w) { return __uint_as_float(w << 16); }
__device__ __forceinline__ float bfhi(unsigned w) { return __uint_as_float(w & 0xffff0000u); }
__device__ __forceinline__ float bf1(u16 h) { return __uint_as_float(((unsigned)h) << 16); }
__device__ __forceinline__ u16 f2bf(float f) { return (u16)(pk2(f, 0.f) & 0xffffu); }
__device__ __forceinline__ float sigmoidf_(float x) { return __builtin_amdgcn_rcpf(1.f + __expf(-x)); }
__device__ __forceinline__ float siluf_(float x) { return x * __builtin_amdgcn_rcpf(1.f + __expf(-x)); }
__device__ __forceinline__ void unpack8(u32x4 w, float* f) {
  f[0] = bflo(w.x); f[1] = bfhi(w.x); f[2] = bflo(w.y); f[3] = bfhi(w.y);
  f[4] = bflo(w.z); f[5] = bfhi(w.z); f[6] = bflo(w.w); f[7] = bfhi(w.w);
}
__device__ __forceinline__ u32x4 pack8(const float* f) {
  u32x4 w; w.x = pk2(f[0], f[1]); w.y = pk2(f[2], f[3]); w.z = pk2(f[4], f[5]); w.w = pk2(f[6], f[7]); return w;
}
__device__ __forceinline__ int otid() { int t = threadIdx.x; asm volatile("" : "+v"(t)); return t; }
__device__ __forceinline__ int obid() { int b = blockIdx.x; asm volatile("" : "+s"(b)); return b; }
__device__ __forceinline__ int pos32(int x) { return (x & ~31) | (((x >> 2) & 3) << 3) | (((x >> 4) & 1) << 2) | (x & 3); }


#define XB_TMO      128
#define XB_XCNT(j)  (256  + 64 * (j))
#define XB_XSUB(j)  (1280 + 64 * (j))
#define XB_XGEN(j)  (2304 + 64 * (j))
#define XB_TOP      3328
#define XB_TOPGEN   3392
#define XCD_BAR_WORDS 3456
#define XB_SPIN_CAP (1u << 20)
__device__ __forceinline__ unsigned xb_ld(unsigned* p)              { return __hip_atomic_load(p, __ATOMIC_RELAXED, __HIP_MEMORY_SCOPE_AGENT); }
__device__ __forceinline__ unsigned xb_add(unsigned* p, unsigned v) { return __hip_atomic_fetch_add(p, v, __ATOMIC_RELAXED, __HIP_MEMORY_SCOPE_AGENT); }
__device__ __forceinline__ unsigned xb_xcc_id() { return (unsigned)__builtin_amdgcn_s_getreg((3 << 11) | 20) & 0xFu; }
#define XB_SPIN(cond, bar) do { unsigned _sp = 0; while (cond) { __builtin_amdgcn_s_sleep(1); \
    if ((++_sp & 255u) == 0u) { if (xb_ld(&(bar)[XB_TMO])) break; if (_sp > XB_SPIN_CAP) { atomicAdd(&(bar)[XB_TMO], 1u); break; } } } } while (0)
struct XcdBarrier { unsigned* bar; unsigned x; volatile LAS unsigned* st; };
__device__ __forceinline__ XcdBarrier xcd_barrier_post(unsigned* bar, volatile LAS unsigned* st) {
    XcdBarrier b; b.bar = bar; b.x = xb_xcc_id(); b.st = st;
    if (threadIdx.x == 0) (void)xb_add(&bar[XB_XCNT(b.x)], 1u);
    return b;
}
__device__ __forceinline__ void xcd_barrier_complete(unsigned* bar, unsigned x, unsigned& nloc, unsigned& nx) {
    const unsigned G = gridDim.x * gridDim.y * gridDim.z;
    unsigned sum, cnt, mine, sp = 0u;
    for (;;) {
        sum = 0u; cnt = 0u; mine = 0u;
#pragma unroll
        for (unsigned j = 0; j < 16; ++j) { const unsigned c = xb_ld(&bar[XB_XCNT(j)]); sum += c; cnt += (c > 0u) ? 1u : 0u; mine = (j == x) ? c : mine; }
        if (sum == G) break;
        __builtin_amdgcn_s_sleep(1);
        if ((++sp & 255u) == 0u) { if (xb_ld(&bar[XB_TMO])) break; if (sp > XB_SPIN_CAP) { atomicAdd(&bar[XB_TMO], 1u); break; } }
    }
    nloc = mine > 0u ? mine : 1u; nx = cnt > 0u ? cnt : 1u;
}
__device__ __forceinline__ void xcd_barrier(const XcdBarrier& b) {
    asm volatile("s_waitcnt vmcnt(0)" ::: "memory");
    __syncthreads();
    if (threadIdx.x == 0) {
        unsigned* bar = b.bar;
        __builtin_amdgcn_s_waitcnt(0);
        unsigned nloc = b.st[0], nx = b.st[1];
        if (nloc == 0u) { xcd_barrier_complete(bar, b.x, nloc, nx); b.st[0] = nloc; b.st[1] = nx; }
        const unsigned old = xb_add(&bar[XB_XSUB(b.x)], 1u);
        const unsigned gen = old / nloc;
        if (old + 1u == (gen + 1u) * nloc) {
            __builtin_amdgcn_fence(__ATOMIC_RELEASE, "agent");
            asm volatile("s_waitcnt vmcnt(0)" ::: "memory");
            const unsigned og = xb_add(&bar[XB_TOP], 1u);
            const unsigned tg = og / nx;
            if (og + 1u == (tg + 1u) * nx) xb_add(&bar[XB_TOPGEN], 1u);
            else XB_SPIN(xb_ld(&bar[XB_TOPGEN]) == tg, bar);
            __builtin_amdgcn_fence(__ATOMIC_ACQUIRE, "agent");
            xb_add(&bar[XB_XGEN(b.x)], 1u);
            asm volatile("s_waitcnt vmcnt(0)" ::: "memory");
        } else {
            XB_SPIN(xb_ld(&bar[XB_XGEN(b.x)]) == gen, bar);
            __builtin_amdgcn_fence(__ATOMIC_ACQUIRE, "agent");
            asm volatile("s_waitcnt vmcnt(0)" ::: "memory");
        }
    }
    __syncthreads();
}

constexpr int BM = 256, BK = 64, HALF = 128, HTB = HALF * BK * 2;
__device__ __forceinline__ int lds_byte(int r, int c) {
  int st = (r >> 4) * 2 + (c >> 5), rr = r & 15, cc = c & 31, ob = rr * 64 + cc * 2;
  return st * 1024 + (ob ^ (((ob >> 9) & 1) << 5));
}
__device__ __forceinline__ void stage_rc(int b, int& R, int& C) {
  int st = b / 1024, sb = b % 1024, swz = sb ^ (((sb >> 9) & 1) << 5);
  R = (st >> 1) * 16 + swz / 64; C = (st & 1) * 32 + (swz % 64) / 2;
}

#define G_SA(b, h) (((b) * 2 + (h)) * HTB)
#define G_SB(b, h) ((4 + (b) * 2 + (h)) * HTB)
#define G_STAGE(bufoff, gptr, voff) do { _Pragma("unroll") for (int _i = 0; _i < 2; ++_i) \
    __builtin_amdgcn_global_load_lds((const unsigned*)((const char*)(gptr) + (voff)[_i]), (LAS unsigned*)(lds + (bufoff) + tid * 16 + _i * 8192), 16, 0, 0); } while (0)
#define G_LDA(dst, b, h) do { _Pragma("unroll") for (int m = 0; m < 4; ++m) _Pragma("unroll") for (int k = 0; k < 2; ++k) \
    dst[m][k] = *(const LAS bf16x8*)(lds + G_SA(b, h) + aoff + m * 2048 + k * 1024); } while (0)
#define G_LDB(dst, b, h) do { _Pragma("unroll") for (int n = 0; n < 2; ++n) _Pragma("unroll") for (int k = 0; k < 2; ++k) \
    dst[n][k] = *(const LAS bf16x8*)(lds + G_SB(b, h) + boff + n * 2048 + k * 1024); } while (0)
#define G_MMA(ai, bj, At, Bt) do { __builtin_amdgcn_s_setprio(1); _Pragma("unroll") for (int m = 0; m < 4; ++m) _Pragma("unroll") for (int n = 0; n < 2; ++n) \
    _Pragma("unroll") for (int k = 0; k < 2; ++k) acc[ai][bj][m][n] = __builtin_amdgcn_mfma_f32_16x16x32_bf16(Bt[n][k], At[m][k], acc[ai][bj][m][n], 0, 0, 0); \
    __builtin_amdgcn_s_setprio(0); } while (0)
#define WAIT_V(n) asm volatile("s_waitcnt vmcnt(" #n ")" ::: "memory")
#define WAIT_L(n) asm volatile("s_waitcnt lgkmcnt(" #n ")" ::: "memory")
#define BAR __builtin_amdgcn_s_barrier()
#define SCHED __builtin_amdgcn_sched_barrier(0)

struct NoTileEpi { __device__ __forceinline__ void operator()(f32x4 (&)[2][2][4][2], int, int) const {} };
__device__ __forceinline__ int perm32r(int rho) { const int n = rho >> 4, i = rho & 15; return 8 * (i >> 2) + 4 * n + (i & 3); }
struct NoMid { __device__ __forceinline__ void operator()(f32x4 (&)[2][2][4][2], int, int) const {} };
struct NoRowEnd { __device__ __forceinline__ void operator()(int) const {} };
template <bool LDSEPI = false, bool PERM = false, class Pre, class Epi, class Tep = NoTileEpi, class Mid = NoMid, class RowEnd = NoRowEnd>
__device__ __forceinline__ void gemm_phase(LAS unsigned char* lds, const u16* A, int lda, const u16* Bt, int ldb, int M, int N, int K, int blk0, int nblk, const Pre& pre, const Epi& epi,
                                           int nM_ = 0, int mstride = BM, int moff = 0, const Tep& tep = Tep(), int nt_mid = -1, const Mid& mid = Mid(), const RowEnd& rowend = RowEnd()) {
  const int tid = otid(), wid = tid >> 6, lane = tid & 63, wr = wid >> 2, wc = wid & 3, fr = lane & 15, fq = lane >> 4;
  const int nt = K / BK;
  unsigned voffA[2], voffB[2];
#pragma unroll
  for (int i = 0; i < 2; ++i) { int R, C; stage_rc(tid * 16 + i * 8192, R, C); const int Rb = PERM ? ((R & ~31) + perm32r(R & 31)) : R;
    voffA[i] = (unsigned)(R * lda + C) * 2u; voffB[i] = (unsigned)(Rb * ldb + C) * 2u; }
  const int aoff = lds_byte(wr * 64 + fr, fq * 8), boff = lds_byte(wc * 32 + fr, fq * 8);
  const int nM = nM_ ? nM_ : M / BM, nN = N / BM, nwg = nM * nN;
  if (blk0 >= nwg) return;
  auto tile_rc = [&](int tile, int& brow, int& bcol) {
    int wgid = tile;
    { int q = nwg / 8, r = nwg % 8, xcd = wgid % 8, off = wgid / 8; wgid = (xcd < r ? xcd * (q + 1) : r * (q + 1) + (xcd - r) * q) + off; }
    const int nig = 8 * nN, gid = wgid / nig, fm = gid * 8, gsz = min(nM - fm, 8);
    const int pm = fm + ((wgid % nig) % gsz), pn = (wgid % nig) / gsz;
    brow = pm * mstride + moff; bcol = pn * BM;
  };
  const size_t hA = (size_t)HALF * lda, hB = (size_t)HALF * ldb;
  int tile = blk0, brow, bcol;
  tile_rc(tile, brow, bcol);
  const u16* Ab = A + (long)brow * lda;
  const u16* Bb = Bt + (size_t)bcol * ldb;
#define G_PROLOGUE do { G_STAGE(G_SB(0, 0), Bb, voffB); G_STAGE(G_SA(0, 0), Ab, voffA); \
  G_STAGE(G_SB(0, 1), Bb + hB, voffB); G_STAGE(G_SA(0, 1), Ab + hA, voffA); \
  if (wr == 1) BAR; \
  WAIT_V(4); BAR; \
  G_STAGE(G_SB(1, 0), Bb + BK, voffB); G_STAGE(G_SA(1, 0), Ab + BK, voffA); G_STAGE(G_SB(1, 1), Bb + hB + BK, voffB); \
  WAIT_V(6); BAR; } while (0)
  if (!LDSEPI) G_PROLOGUE;
  for (; tile < nwg; tile += nblk) {
    if (LDSEPI) G_PROLOGUE;
    const int ntile = tile + nblk < nwg ? tile + nblk : tile;
    int nbrow, nbcol;
    tile_rc(ntile, nbrow, nbcol);
    const u16* nAb = A + (long)nbrow * lda;
    const u16* nBb = Bt + (size_t)nbcol * ldb;
    f32x4 acc[2][2][4][2];
#pragma unroll
    for (int a = 0; a < 2; ++a)
#pragma unroll
      for (int b = 0; b < 2; ++b)
#pragma unroll
        for (int m = 0; m < 4; ++m)
#pragma unroll
          for (int n = 0; n < 2; ++n) acc[a][b][m][n] = (f32x4){0.f, 0.f, 0.f, 0.f};
    bf16x8 At[4][2], B0[2][2], B1[2][2];
    for (int t = 0; t < nt; t += 2) {
      if (t == nt_mid) mid(acc, brow, bcol);
      const bool lastp = t + 2 >= nt;
      const bool pf = !(LDSEPI && lastp);
      const u16* A2 = lastp ? nAb : Ab + (t + 2) * BK;
      const u16* B2 = lastp ? nBb : Bb + (t + 2) * BK;
      const u16* A1h = Ab + hA + (t + 1) * BK;
      G_LDB(B0, 0, 0); SCHED; G_LDA(At, 0, 0); G_STAGE(G_SA(1, 1), A1h, voffA);
      WAIT_L(8); BAR; WAIT_L(0); G_MMA(0, 0, At, B0); BAR; SCHED;
      G_LDB(B1, 0, 1); if (pf) G_STAGE(G_SB(0, 0), B2, voffB);
      BAR; WAIT_L(0); G_MMA(0, 1, At, B1); BAR;
      G_LDA(At, 0, 1); if (pf) G_STAGE(G_SA(0, 0), A2, voffA);
      BAR; WAIT_L(0); G_MMA(1, 0, At, B0); BAR; SCHED;
      if (pf) { G_STAGE(G_SB(0, 1), B2 + hB, voffB); WAIT_V(6); } else WAIT_V(0);
      BAR; G_MMA(1, 1, At, B1); BAR;
      G_LDB(B0, 1, 0); SCHED; G_LDA(At, 1, 0); if (pf) G_STAGE(G_SA(0, 1), A2 + hA, voffA);
      WAIT_L(8); BAR; WAIT_L(0); G_MMA(0, 0, At, B0); BAR; SCHED;
      G_LDB(B1, 1, 1); if (pf) G_STAGE(G_SB(1, 0), B2 + BK, voffB);
      BAR; WAIT_L(0); G_MMA(0, 1, At, B1); BAR;
      G_LDA(At, 1, 1); if (pf) G_STAGE(G_SA(1, 0), A2 + BK, voffA);
      BAR; WAIT_L(0); G_MMA(1, 0, At, B0); BAR; SCHED;
      if (pf) G_STAGE(G_SB(1, 1), B2 + hB + BK, voffB);
      WAIT_V(6); BAR; G_MMA(1, 1, At, B1); BAR;
    }
    if (LDSEPI) {
      if (wr == 0) BAR;
      tep(acc, brow, bcol);
    } else if constexpr (PERM) {
#pragma unroll
      for (int ai = 0; ai < 2; ++ai)
#pragma unroll
        for (int m = 0; m < 4; ++m)
#pragma unroll
          for (int bj = 0; bj < 2; ++bj)
            epi(brow + ai * HALF + wr * 64 + m * 16 + fr, bcol + bj * HALF + wc * 32 + fq * 8, acc[ai][bj][m][0], acc[ai][bj][m][1]);
    } else {
#pragma unroll
    for (int ai = 0; ai < 2; ++ai)
#pragma unroll
      for (int m2 = 0; m2 < 4; m2 += 2) {
        u32x4 pv[2][2][2];
#pragma unroll
        for (int mm = 0; mm < 2; ++mm)
#pragma unroll
          for (int bj = 0; bj < 2; ++bj)
#pragma unroll
            for (int n = 0; n < 2; ++n)
              pv[mm][bj][n] = pre(brow + ai * HALF + wr * 64 + (m2 + mm) * 16 + fr, bcol + bj * HALF + wc * 32 + n * 16 + fq * 4);
#pragma unroll
        for (int mm = 0; mm < 2; ++mm) {
#pragma unroll
          for (int bj = 0; bj < 2; ++bj)
#pragma unroll
            for (int n = 0; n < 2; ++n)
              epi(brow + ai * HALF + wr * 64 + (m2 + mm) * 16 + fr, bcol + bj * HALF + wc * 32 + n * 16 + fq * 4, acc[ai][bj][m2 + mm][n], pv[mm][bj][n]);
          rowend(brow + ai * HALF + wr * 64 + (m2 + mm) * 16 + fr);
        }
      }
    }
    if (LDSEPI) WAIT_V(0);
    Ab = nAb; Bb = nBb; brow = nbrow; bcol = nbcol;
  }
  if (!LDSEPI) { WAIT_V(0); if (wr == 0) BAR; }
}

template <class F>
__device__ __forceinline__ void transpose_w(const float* src, int Nsrc, u16* dst, int Ndst, int K, F nsrc_of, int gtid, int gsz, const float* kscale = nullptr, int ldd = 0) {
  if (ldd == 0) ldd = K;
  const int total = Ndst * (K / 32);
  for (int idx = gtid; idx < total; idx += gsz) {
    const int n = idx % Ndst, k32 = idx / Ndst;
    const int ns = nsrc_of(n);
    float v[32];
#pragma unroll
    for (int i = 0; i < 32; ++i) v[i] = ns >= 0 ? src[(size_t)(k32 * 32 + i) * Nsrc + ns] : 0.f;
    if (kscale) {
#pragma unroll
      for (int i = 0; i < 32; ++i) v[i] *= kscale[k32 * 32 + i];
    }
#pragma unroll
    for (int c = 0; c < 4; ++c) *(u32x4*)(dst + (size_t)n * ldd + k32 * 32 + c * 8) = pack8(v + c * 8);
  }
}

template <int CTRL> __device__ __forceinline__ float dpp_add(float v) {
  return v + __int_as_float(__builtin_amdgcn_update_dpp(0, __float_as_int(v), CTRL, 0xF, 0xF, true));
}
__device__ __forceinline__ float red16(float v) {
  v = dpp_add<0xB1>(v); v = dpp_add<0x4E>(v); v = dpp_add<0x141>(v); v = dpp_add<0x140>(v);
  return v;
}
__device__ __forceinline__ float wave_sum(float v) {
  v = red16(v); v += __shfl_xor(v, 16); v += __shfl_xor(v, 32);
  return v;
}

__device__ __forceinline__ void rmsnorm_rows_bf16(const float* in, const float* w, u16* out, int gtid, int gsz) {
  const int lane = gtid & 63, nw = gsz >> 6;
  for (int r0 = gtid >> 6; r0 < T; r0 += 2 * nw) {
    f32x4 v[2][4]; float ss[2] = {0.f, 0.f};
#pragma unroll
    for (int u = 0; u < 2; ++u) {
      const int r = min(r0 + u * nw, T - 1);
      const f32x4* xr = (const f32x4*)(in + (size_t)r * 1024);
#pragma unroll
      for (int i = 0; i < 4; ++i) v[u][i] = xr[i * 64 + lane];
    }
#pragma unroll
    for (int u = 0; u < 2; ++u) {
#pragma unroll
      for (int i = 0; i < 4; ++i) ss[u] += v[u][i][0] * v[u][i][0] + v[u][i][1] * v[u][i][1] + v[u][i][2] * v[u][i][2] + v[u][i][3] * v[u][i][3];
      ss[u] = wave_sum(ss[u]);
    }
#pragma unroll
    for (int u = 0; u < 2; ++u) {
      const int r = r0 + u * nw;
      if (r < T) {
        const float rs = rsqrtf(ss[u] * (1.f / 1024.f) + 1e-6f);
#pragma unroll
        for (int i = 0; i < 4; ++i) {
          const f32x4 ww = ((const f32x4*)w)[i * 64 + lane];
          u32x2 o; o.x = pk2(v[u][i][0] * rs * ww[0], v[u][i][1] * rs * ww[1]); o.y = pk2(v[u][i][2] * rs * ww[2], v[u][i][3] * rs * ww[3]);
          *(u32x2*)(out + (size_t)r * 1024 + (i * 64 + lane) * 4) = o;
        }
      }
    }
  }
}

__device__ __forceinline__ void phase_prep(const Params& p) {
  const int tid0 = otid();
  unsigned char* ws = p.ws;
  if (tid0 < 256) {
    rmsnorm_rows_bf16(p.x, p.norm1_w, (u16*)(ws + O_HB), obid() * 256 + tid0, NBLK * 256);
    for (int i = obid() * 256 + tid0; i < T; i += NBLK * 256) ((float*)(ws + O_SSQ))[i] = 0.f;
    return;
  }
  const int gtid = obid() * 256 + (tid0 - 256), gsz = NBLK * 256;
  transpose_w(p.w_in, 6688, (u16*)(ws + O_WIN), 6912, 1024, [](int n) {
    if (n < 3072) return 512 + n;
    if (n < 3584) return n - 3072;
    if (n < 3616) return 4608 + (n - 3584);
    if (n < 3840) return -1;
    const int m = n - 3840;
    return m < 1024 ? 3584 + m : 4640 + (m - 1024); }, gtid, gsz);
  transpose_w(p.ffn_up, 5632, (u16*)(ws + O_UP), 5632, 1024, [](int n) {
    const int pn = n >> 8, r = n & 255;
    return r < 128 ? pn * 128 + r : 2816 + pn * 128 + (r - 128); }, gtid, gsz, p.norm2_w);
  transpose_w(p.ffn_down, 1024, (u16*)(ws + O_DN), 1024, 2816, [](int n) { return n; }, gtid, gsz);
  transpose_w(p.dn_out, 1024, (u16*)(ws + O_BC) + 512, 1024, 1024, [](int n) { return n; }, gtid, gsz, nullptr, 1536);
  transpose_w(p.w_o, 1024, (u16*)(ws + O_WO), 1024, 1024, [](int n) { return n; }, gtid, gsz);
  for (int idx = gtid; idx < 1024 * 128; idx += gsz) {
    const int n = idx & 1023, k4 = idx >> 10, g = k4 >> 5, c0 = (k4 & 31) * 4;
    float a[4] = {0, 0, 0, 0};
#pragma unroll 2
    for (int d0 = 0; d0 < 128; d0 += 8) {
      float po[8];
#pragma unroll
      for (int dd = 0; dd < 8; ++dd) po[dd] = p.pool_out[(size_t)(g * 128 + d0 + dd) * 1024 + n];
      const f32x4 s0 = *(const f32x4*)(p.pool_scale + g * 128 + d0), s1 = *(const f32x4*)(p.pool_scale + g * 128 + d0 + 4);
      po[0] *= s0[0]; po[1] *= s0[1]; po[2] *= s0[2]; po[3] *= s0[3]; po[4] *= s1[0]; po[5] *= s1[1]; po[6] *= s1[2]; po[7] *= s1[3];
#pragma unroll
      for (int i = 0; i < 4; ++i) {
        const float* wr_ = p.pool_w + (size_t)((g * 128 + c0 + i) * 128) + d0;
        const f32x4 w0 = *(const f32x4*)wr_, w1 = *(const f32x4*)(wr_ + 4);
        a[i] += w0[0] * po[0] + w0[1] * po[1] + w0[2] * po[2] + w0[3] * po[3] + w1[0] * po[4] + w1[1] * po[5] + w1[2] * po[6] + w1[3] * po[7];
      }
    }
    u32x2 o; o.x = pk2(a[0], a[1]); o.y = pk2(a[2], a[3]);
    *(u32x2*)((u16*)(ws + O_BC) + (size_t)n * 1536 + k4 * 4) = o;
  }
}

constexpr int PQ = 0, PK = 17408, PV = 34816, PL = 52224, PS = 68608, PT = 69888, PHALF = 71936;

#define DP_IDS const int tid = otid(), dir = tid >> 8, ht = tid & 255, hw = (tid >> 6) & 3, lane = tid & 63, fr = lane & 15, fq = lane >> 4; \
  LAS unsigned char* L = lds + dir * PHALF; LAS float* Gs = (LAS float*)(L + PS); LAS float* Bs = Gs + 64; LAS float* EGs = Gs + 128; \
  LAS float* KDs = Gs + 192; LAS float* CWs = Gs + 256; (void)hw; (void)fr; (void)fq; (void)ht; (void)Bs; (void)EGs; (void)KDs; (void)CWs; (void)lane; \
  const int mstep = stage * CPS + j, n_orig = dir ? 63 - mstep : mstep, chain = bh * 2 + dir; (void)n_orig; \
  unsigned char* ops = p.ws + O_OPS + (size_t)(chain * CPS + j) * OPS_BYTES; (void)ops;
__device__ __forceinline__ void phase_dprep(const Params& p, LAS unsigned char* lds, int stage) {
  const u16* qkv = (const u16*)(p.ws + O_QKV);
  const float* gates = (const float*)(p.ws + O_GATES);
  float* glbuf = (float*)(p.ws + O_GL);
  u32x4 raw[12];
  float pg = 0.f, pbeta = 0.f;
  auto prefetch = [&](int item_) {
    const int bh = item_ / CPS, j = item_ % CPS, b = bh >> 3, h = bh & 7;
    const int tid = otid(), dir = tid >> 8, ht = tid & 255, hw = (tid >> 6) & 3, lane = tid & 63;
    const int mstep = stage * CPS + j, n_orig = dir ? 63 - mstep : mstep;
    const size_t tok0 = (size_t)b * SEQ + (size_t)n_orig * 64;
#pragma unroll
    for (int k = 0; k < 12; ++k) {
      const int idx = ht + k * 256, mat = idx >> 10, row = (idx >> 4) & 63, cgp = idx & 15;
      raw[k] = *(const u32x4*)(qkv + (tok0 + row) * 3072 + mat * 1024 + h * 128 + cgp * 8);
    }
    if (hw == 3) {
      const int row = dir ? 63 - lane : lane;
      const float* gp = gates + (tok0 + row) * 32;
      pg = gp[16 + dir * 8 + h]; pbeta = gp[dir * 8 + h];
    }
  };
  if (obid() < 64 * CPS) prefetch(obid());
  for (int item = obid(); item < 64 * CPS; item += NBLK) {
    const int bh = item / CPS, j = item % CPS;
    {
      DP_IDS
#pragma unroll
      for (int k = 0; k < 12; ++k) {
        const int idx = ht + k * 256, mat = idx >> 10, row = (idx >> 4) & 63, cgp = idx & 15, lrow = dir ? 63 - row : row;
        *(LAS u32x4*)(L + mat * 17408 + lrow * 272 + cgp * 16) = raw[k];
      }
      if (hw == 3) {
        float g = pg;
        const float beta = pbeta;
#pragma unroll
        for (int o = 1; o < 64; o <<= 1) { const float t = __shfl_up(g, o); if (lane >= o) g += t; }
        const float glast = __shfl(g, 63);
        Gs[lane] = g; Bs[lane] = beta; EGs[lane] = __expf(g); KDs[lane] = __expf(glast - g); CWs[lane] = beta * __expf(g);
        if (lane == 63) glbuf[chain * 64 + mstep] = __expf(g);
      }
    }
    __syncthreads();
    for (int rep = 0; rep < ((DP_DUP & 2) ? 2 : 1); ++rep) {
      DP_IDS
      bf16x8 ka[4], qa[4];
#pragma unroll
      for (int kb = 0; kb < 4; ++kb) {
        ka[kb] = *(const LAS bf16x8*)(L + PK + (hw * 16 + fr) * 272 + (kb * 32 + fq * 8) * 2);
        qa[kb] = *(const LAS bf16x8*)(L + PQ + (hw * 16 + fr) * 272 + (kb * 32 + fq * 8) * 2);
      }
      u16* attg = (u16*)(ops + 65536);
      LAS float* Ls = (LAS float*)(L + PL);
#pragma unroll
      for (int nt = 0; nt < 4; ++nt) {
        f32x4 kk = {0.f, 0.f, 0.f, 0.f}, qk = {0.f, 0.f, 0.f, 0.f};
#pragma unroll
        for (int kb = 0; kb < 4; ++kb) {
          const bf16x8 kbf = *(const LAS bf16x8*)(L + PK + (nt * 16 + fr) * 272 + (kb * 32 + fq * 8) * 2);
          kk = __builtin_amdgcn_mfma_f32_16x16x32_bf16(ka[kb], kbf, kk, 0, 0, 0);
          qk = __builtin_amdgcn_mfma_f32_16x16x32_bf16(kbf, qa[kb], qk, 0, 0, 0);
        }
        const int jj = nt * 16 + fr;
        const float gj = Gs[jj];
#pragma unroll
        for (int r = 0; r < 4; ++r) {
          const int ii = hw * 16 + fq * 4 + r;
          const float dec = __expf(fminf(Gs[ii] - gj, 0.f));
          Ls[ii * 64 + jj] = ii > jj ? Bs[ii] * kk[r] * dec : 0.f;
        }
        {
          const int ia = hw * 16 + fr, j0 = nt * 16 + fq * 4;
          const float gi = Gs[ia];
          f32x4 av;
#pragma unroll
          for (int r = 0; r < 4; ++r) av[r] = ia >= j0 + r ? qk[r] * __expf(fminf(gi - Gs[j0 + r], 0.f)) : 0.f;
          u32x2 o; o.x = pk2(av[0], av[1]); o.y = pk2(av[2], av[3]);
          *(u32x2*)(attg + ia * 64 + pos32(j0)) = o;
        }
      }
      asm volatile("s_waitcnt lgkmcnt(0)" ::: "memory");
      {
        const LAS float* Ld = Ls + (hw * 16) * 64 + hw * 16;
        float t[16];
#pragma unroll
        for (int i = 0; i < 16; ++i) {
          float a = (i == fr) ? 1.f : 0.f;
#pragma unroll
          for (int j4 = 0; j4 < (i + 3) / 4; ++j4) {
            const f32x4 l = *(const LAS f32x4*)(Ld + i * 64 + j4 * 4);
#pragma unroll
            for (int jj = 0; jj < 4; ++jj) if (j4 * 4 + jj < i) a -= l[jj] * t[j4 * 4 + jj];
          }
          t[i] = a;
        }
        if (fq == 0) {
          LAS u16* Tb = (LAS u16*)(L + PT) + hw * 256 + fr;
#pragma unroll
          for (int i = 0; i < 16; ++i) Tb[i * 16] = f2bf(i == fr ? 0.f : t[i]);
        }
      }
    }
    __syncthreads();
    if (item + NBLK < 64 * CPS) prefetch(item + NBLK);
    {
      DP_IDS
      {
        const int c = ht >> 2, kb = ht & 3;
        const float eg = EGs[c];
        float in[32], out[32];
#pragma unroll
        for (int v = 0; v < 4; ++v) { const u32x4 raw = *(const LAS u32x4*)(L + PQ + c * 272 + (kb * 32 + v * 8) * 2); unpack8(raw, in + v * 8); }
#pragma unroll
        for (int x = 0; x < 32; ++x) out[pos32(x)] = in[x] * eg;
#pragma unroll
        for (int v = 0; v < 4; ++v) *(u32x4*)(ops + 16384 + c * 256 + kb * 64 + v * 16) = pack8(out + v * 8);
      }
      __builtin_amdgcn_sched_barrier(0);
      {
        const int d = ht >> 1, cb = ht & 1;
        float out[32];
#pragma unroll
        for (int x = 0; x < 32; ++x) { const int c = cb * 32 + x; out[pos32(x)] = bf1(*(const LAS u16*)(L + PK + c * 272 + d * 2)) * KDs[c]; }
#pragma unroll
        for (int v = 0; v < 4; ++v) *(u32x4*)(ops + 32768 + d * 128 + cb * 64 + v * 16) = pack8(out + v * 8);
      }
      __builtin_amdgcn_sched_barrier(0);
      typedef short s16x4 __attribute__((ext_vector_type(4)));
      const LAS float* Ls = (const LAS float*)(L + PL);
      s16x4 Lf[6], Tf[4];
      {
        int n = 0;
#pragma unroll
        for (int I = 1; I < 4; ++I)
#pragma unroll
          for (int J = 0; J < I; ++J) {
            const f32x4 l = *(const LAS f32x4*)(Ls + (16 * I + fr) * 64 + 16 * J + 4 * fq);
            u32x2 pk; pk.x = pk2(l[0], l[1]); pk.y = pk2(l[2], l[3]);
            Lf[n++] = __builtin_bit_cast(s16x4, pk);
          }
#pragma unroll
        for (int I = 0; I < 4; ++I) Tf[I] = *(const LAS s16x4*)(L + PT + ((16 * I + fr) * 16 + 4 * fq) * 2);
      }
      const bool isw = hw < 2;
      const LAS float* cf = isw ? CWs : Bs;
      unsigned wpk[32];
#pragma unroll
      for (int k = 0; k < 32; ++k) wpk[k] = 0u;
#pragma unroll
      for (int tt = 0; tt < 4; ++tt) {
        const int col = ((hw & 1) * 4 + tt) * 16 + fr;
        const LAS unsigned char* src = L + (isw ? PK : PV) + col * 2;
        s16x4 Xb[4];
#pragma unroll
        for (int I = 0; I < 4; ++I) {
          f32x4 acc = {0.f, 0.f, 0.f, 0.f};
#pragma unroll
          for (int J = 0; J < I; ++J) acc = __builtin_amdgcn_mfma_f32_16x16x16bf16_1k(Lf[I * (I - 1) / 2 + J], Xb[J], acc, 0, 0, 0);
          const f32x4 cfi = *(const LAS f32x4*)(cf + 16 * I + 4 * fq);
          f32x4 y;
#pragma unroll
          for (int r = 0; r < 4; ++r) y[r] = bf1(*(const LAS u16*)(src + (16 * I + 4 * fq + r) * 272)) * cfi[r] - acc[r];
          u32x2 yp; yp.x = pk2(y[0], y[1]); yp.y = pk2(y[2], y[3]);
          const f32x4 x = __builtin_amdgcn_mfma_f32_16x16x16bf16_1k(Tf[I], __builtin_bit_cast(s16x4, yp), y, 0, 0, 0);
          u32x2 xp; xp.x = pk2(x[0], x[1]); xp.y = pk2(x[2], x[3]);
          Xb[I] = __builtin_bit_cast(s16x4, xp);
          if (isw) { wpk[tt * 8 + I * 2] = xp.x; wpk[tt * 8 + I * 2 + 1] = xp.y; }
          else *(u32x2*)(ops + 49152 + col * 128 + (16 * I + 4 * fq) * 2) = xp;
        }
      }
      __syncthreads();
      if (isw) {
#pragma unroll
        for (int tt = 0; tt < 4; ++tt) {
          const int d = (hw * 4 + tt) * 16 + fr;
          LAS unsigned char* wst = L + PQ + pos32(d) * 2;
#pragma unroll
          for (int I = 0; I < 4; ++I)
#pragma unroll
            for (int r = 0; r < 4; ++r) {
              const unsigned wv = wpk[tt * 8 + I * 2 + (r >> 1)];
              *(LAS u16*)(wst + (16 * I + 4 * fq + r) * 256) = (u16)((r & 1) ? (wv >> 16) : (wv & 0xffffu));
            }
        }
      }
      __syncthreads();
#pragma unroll
      for (int v = 0; v < 4; ++v) { const int idx = ht + v * 256; *(u32x4*)(ops + idx * 16) = *(const LAS u32x4*)(L + PQ + idx * 16); }
    }
    __syncthreads();
  }
}

constexpr int SW = 0, SQ = 17408, SK = 34816, SA_ = 53248, SBUF = 62464;

__device__ __forceinline__ void scan_load(const unsigned char* ops, u32x4 (&r)[7], int tid) {
#pragma unroll
  for (int i = 0; i < 6; ++i) r[i] = *(const u32x4*)(ops + (size_t)(i * 512 + tid) * 16);
  r[6] = *(const u32x4*)(ops + 65536 + (size_t)tid * 16);
}
__device__ __forceinline__ void scan_store(LAS unsigned char* buf, const u32x4 (&r)[7], int tid) {
#pragma unroll
  for (int i = 0; i < 6; ++i) {
    const int idx = i * 512 + tid;
    int off;
    if (idx < 2048) { const int m = idx >> 10, e = idx & 1023; off = m * 17408 + (e >> 4) * 272 + (e & 15) * 16; }
    else { const int e = idx - 2048; off = SK + (e >> 3) * 144 + (e & 7) * 16; }
    *(LAS u32x4*)(buf + off) = r[i];
  }
  *(LAS u32x4*)(buf + SA_ + (tid >> 3) * 144 + (tid & 7) * 16) = r[6];
}

__device__ __forceinline__ void phase_scan(const Params& p, LAS unsigned char* lds, int stage, bool save) {
  const int bid = obid();
  if (bid >= 256) return;
  const int chain = (bid >> 4) * 8 + (bid & 7), eh = (bid >> 3) & 1;
  const int tid = otid(), wv = tid >> 6, lane = tid & 63, fr = lane & 15, fq = lane >> 4;
  const bool comp = wv < 4;
  const int w = eh * 4 + (wv & 3);
  const int bh = chain >> 1, dir = chain & 1, b = bh >> 3, h = bh & 7;
  const unsigned char* opsb = p.ws + O_OPS + (size_t)chain * CPS * OPS_BYTES;
  const float* glbuf = (const float*)(p.ws + O_GL) + chain * 64;
  float* sst = (float*)(p.ws + O_PM) + (size_t)chain * 16384 + w * 2048 + lane;
  u16* og = (u16*)p.out + (size_t)dir * T * 1024;
  f32x4 S[8];
#pragma unroll
  for (int dt = 0; dt < 8; ++dt)
#pragma unroll
    for (int r = 0; r < 4; ++r) S[dt][r] = stage == 0 ? 0.f : sst[(dt * 4 + r) * 64];
  u32x4 stgA[14], stgB[14];
  const int lt = tid - 256;
  auto ld_ops = [&](const unsigned char* o_, u32x4 (&stg)[14]) {
    if (!comp) {
#pragma unroll
      for (int i = 0; i < 12; ++i) stg[i] = *(const u32x4*)(o_ + (size_t)(i * 256 + lt) * 16);
#pragma unroll
      for (int i = 0; i < 2; ++i) stg[12 + i] = *(const u32x4*)(o_ + 65536 + (size_t)(i * 256 + lt) * 16);
    }
  };
  auto st_ops = [&](LAS unsigned char* buf, const u32x4 (&stg)[14]) {
    if (!comp) {
#pragma unroll
      for (int i = 0; i < 12; ++i) {
        const int idx = i * 256 + lt;
        int off;
        if (idx < 2048) { const int m = idx >> 10, e = idx & 1023; off = m * 17408 + (e >> 4) * 272 + (e & 15) * 16; }
        else { const int e = idx - 2048; off = SK + (e >> 3) * 144 + (e & 7) * 16; }
        *(LAS u32x4*)(buf + off) = stg[i];
      }
#pragma unroll
      for (int i = 0; i < 2; ++i) { const int idx = i * 256 + lt; *(LAS u32x4*)(buf + SA_ + (idx >> 3) * 144 + (idx & 7) * 16) = stg[12 + i]; }
    }
  };
  u32x2 unx[4];
  float gln = glbuf[stage * CPS];
#pragma unroll
  for (int mt = 0; mt < 4; ++mt) unx[mt] = *(const u32x2*)(opsb + 49152 + (w * 16 + fr) * 128 + (mt * 16 + fq * 4) * 2);
  ld_ops(opsb, stgA);
  st_ops(lds, stgA);
  ld_ops(opsb + OPS_BYTES, stgA);
  __syncthreads();
  if (!comp) {
    for (int j = 0; j < CPS; j += 2) {
      if (j + 2 < CPS) ld_ops(opsb + (size_t)(j + 2) * OPS_BYTES, stgB);
      st_ops(lds + SBUF, stgA);
      __syncthreads();
      if (j + 3 < CPS) ld_ops(opsb + (size_t)(j + 3) * OPS_BYTES, stgA);
      if (j + 2 < CPS) st_ops(lds, stgB);
      __syncthreads();
    }
    return;
  }
  for (int j = 0; j < CPS; ++j) {
    LAS unsigned char* cur = lds + (j & 1) * SBUF;
    const unsigned char* ops = opsb + (size_t)j * OPS_BYTES;
    const int mstep = stage * CPS + j;
    {
    const float gl = gln;
    u32x2 uraw[4];
#pragma unroll
    for (int mt = 0; mt < 4; ++mt) uraw[mt] = unx[mt];
    if (j + 1 < CPS) {
      gln = glbuf[mstep + 1];
#pragma unroll
      for (int mt = 0; mt < 4; ++mt) unx[mt] = *(const u32x2*)(ops + OPS_BYTES + 49152 + (w * 16 + fr) * 128 + (mt * 16 + fq * 4) * 2);
    }
    bf16x8 Sb[4];
#pragma unroll
    for (int kb = 0; kb < 4; ++kb) {
      u32x4 t; t.x = pk2(S[2 * kb][0], S[2 * kb][1]); t.y = pk2(S[2 * kb][2], S[2 * kb][3]); t.z = pk2(S[2 * kb + 1][0], S[2 * kb + 1][1]); t.w = pk2(S[2 * kb + 1][2], S[2 * kb + 1][3]);
      Sb[kb] = __builtin_bit_cast(bf16x8, t);
    }
    f32x4 X[4], O[4];
#pragma unroll
    for (int mh = 0; mh < 2; ++mh) {
      bf16x8 wa[2][4], qa[2][4];
#pragma unroll
      for (int m2 = 0; m2 < 2; ++m2)
#pragma unroll
        for (int kb = 0; kb < 4; ++kb) {
          wa[m2][kb] = *(const LAS bf16x8*)(cur + SW + ((mh * 2 + m2) * 16 + fr) * 272 + (kb * 32 + fq * 8) * 2);
          qa[m2][kb] = *(const LAS bf16x8*)(cur + SQ + ((mh * 2 + m2) * 16 + fr) * 272 + (kb * 32 + fq * 8) * 2);
        }
      __builtin_amdgcn_sched_barrier(0);
#pragma unroll
      for (int m2 = 0; m2 < 2; ++m2) {
        const int mt = mh * 2 + m2;
        f32x4 ws_ = {0.f, 0.f, 0.f, 0.f}, o = {0.f, 0.f, 0.f, 0.f};
#pragma unroll
        for (int kb = 0; kb < 4; ++kb) {
          ws_ = __builtin_amdgcn_mfma_f32_16x16x32_bf16(wa[m2][kb], Sb[kb], ws_, 0, 0, 0);
          o = __builtin_amdgcn_mfma_f32_16x16x32_bf16(Sb[kb], qa[m2][kb], o, 0, 0, 0);
        }
        X[mt][0] = bflo(uraw[mt].x) - ws_[0]; X[mt][1] = bfhi(uraw[mt].x) - ws_[1]; X[mt][2] = bflo(uraw[mt].y) - ws_[2]; X[mt][3] = bfhi(uraw[mt].y) - ws_[3];
        O[mt] = o;
      }
      __builtin_amdgcn_sched_barrier(0);
    }
    bf16x8 aa[4][2], ka[8][2];
#pragma unroll
    for (int mt = 0; mt < 4; ++mt)
#pragma unroll
      for (int kb = 0; kb < 2; ++kb) aa[mt][kb] = *(const LAS bf16x8*)(cur + SA_ + (mt * 16 + fr) * 144 + (kb * 32 + fq * 8) * 2);
#pragma unroll
    for (int dt = 0; dt < 8; ++dt)
#pragma unroll
      for (int kb = 0; kb < 2; ++kb) ka[dt][kb] = *(const LAS bf16x8*)(cur + SK + (dt * 16 + fr) * 144 + (kb * 32 + fq * 8) * 2);
    __builtin_amdgcn_sched_barrier(0);
    bf16x8 Xb[2];
#pragma unroll
    for (int kb = 0; kb < 2; ++kb) {
      u32x4 t; t.x = pk2(X[2 * kb][0], X[2 * kb][1]); t.y = pk2(X[2 * kb][2], X[2 * kb][3]); t.z = pk2(X[2 * kb + 1][0], X[2 * kb + 1][1]); t.w = pk2(X[2 * kb + 1][2], X[2 * kb + 1][3]);
      Xb[kb] = __builtin_bit_cast(bf16x8, t);
    }
#pragma unroll
    for (int mt = 0; mt < 4; ++mt)
#pragma unroll
      for (int kb = 0; kb < 2; ++kb) O[mt] = __builtin_amdgcn_mfma_f32_16x16x32_bf16(Xb[kb], aa[mt][kb], O[mt], 0, 0, 0);
#pragma unroll
    for (int dt = 0; dt < 8; ++dt) {
      f32x4 s = S[dt] * gl;
#pragma unroll
      for (int kb = 0; kb < 2; ++kb) s = __builtin_amdgcn_mfma_f32_16x16x32_bf16(ka[dt][kb], Xb[kb], s, 0, 0, 0);
      S[dt] = s;
    }
    __builtin_amdgcn_sched_barrier(0);
    const int n_orig = dir ? 63 - mstep : mstep;
#pragma unroll
    for (int mt = 0; mt < 4; ++mt) {
      const int c = mt * 16 + fr, row = dir ? 63 - c : c;
      u32x2 o; o.x = pk2(O[mt][0], O[mt][1]); o.y = pk2(O[mt][2], O[mt][3]);
      *(u32x2*)(og + ((size_t)b * SEQ + n_orig * 64 + row) * 1024 + h * 128 + w * 16 + fq * 4) = o;
    }
    }
    __syncthreads();
  }
  if (save) {
#pragma unroll
    for (int dt = 0; dt < 8; ++dt)
#pragma unroll
      for (int r = 0; r < 4; ++r) sst[(dt * 4 + r) * 64] = S[dt][r];
  }
}

template <int W>
__device__ __forceinline__ void pool_pm_task(const u16* P, u16* PMo, int tok, int c8) {
  const int pos = tok & (SEQ - 1);
  const int st = pos - W / 2;
  const u16* base = P + (size_t)(tok - pos) * 512 + c8 * 8;
  u32x4 raw[W];
#pragma unroll
  for (int k = 0; k < W; ++k) { const int q = min(max(st + k, 0), SEQ - 1); raw[k] = *(const u32x4*)(base + (size_t)q * 512); }
  float s[8] = {0, 0, 0, 0, 0, 0, 0, 0}, me[8];
  int cnt = 0;
#pragma unroll
  for (int k = 0; k < W; ++k) {
    const int q = st + k;
    float f[8]; unpack8(raw[k], f);
    if (q >= 0 && q < SEQ) {
      ++cnt;
#pragma unroll
      for (int i = 0; i < 8; ++i) s[i] += f[i];
    }
    if (k == W / 2) {
#pragma unroll
      for (int i = 0; i < 8; ++i) me[i] = f[i];
    }
  }
  const float inv = 1.f / (float)cnt;
#pragma unroll
  for (int i = 0; i < 8; ++i) s[i] = s[i] * inv - me[i];
  *(u32x4*)(PMo + (size_t)tok * 1536 + c8 * 8) = pack8(s);
}
__device__ __forceinline__ void phase_pool_pm(const Params& p) {
  const u16* P = (const u16*)(p.ws + O_P);
  u16* PMo = (u16*)(p.ws + O_AC);
  const int gtid = obid() * 512 + otid(), gsz = NBLK * 512;
  for (int idx = gtid; idx < T * 64; idx += gsz) {
    const int wv = idx >> 6, lane = idx & 63, g = wv & 3, tok = (wv >> 2) * 4 + (lane >> 4), c8 = g * 16 + (lane & 15);
    if (g == 0) pool_pm_task<2>(P, PMo, tok, c8);
    else if (g == 1) pool_pm_task<4>(P, PMo, tok, c8);
    else if (g == 2) pool_pm_task<8>(P, PMo, tok, c8);
    else pool_pm_task<16>(P, PMo, tok, c8);
  }
}

__device__ __forceinline__ void phase_onorm(const Params& p) {
  const u16* of = (const u16*)p.out;
  const u16* ob = of + (size_t)T * 1024;
  const u16* zg = (const u16*)(p.ws + O_QKV);
  u16* on = (u16*)(p.ws + O_AC) + 512;
  const int gtid = obid() * 512 + otid(), gsz = NBLK * 512;
  for (int idx0 = gtid; idx0 < T * 128; idx0 += 4 * gsz) {
    u32x4 ra[4], rb[4], rz[4];
#pragma unroll
    for (int u = 0; u < 4; ++u) {
      const int idx = min(idx0 + u * gsz, T * 128 - 1), tok = idx >> 7, c8 = idx & 127;
      ra[u] = *(const u32x4*)(of + (size_t)tok * 1024 + c8 * 8);
      rb[u] = *(const u32x4*)(ob + (size_t)tok * 1024 + c8 * 8);
      rz[u] = *(const u32x4*)(zg + (size_t)tok * 3072 + c8 * 8);
    }
#pragma unroll
    for (int u = 0; u < 4; ++u) {
    const int idx = idx0 + u * gsz;
    if (idx >= T * 128) break;
    const int tok = idx >> 7, c8 = idx & 127;
    float a[8], bb[8], z[8];
    unpack8(ra[u], a);
    unpack8(rb[u], bb);
    unpack8(rz[u], z);
    float ss = 0.f;
#pragma unroll
    for (int i = 0; i < 8; ++i) { a[i] += bb[i]; ss += a[i] * a[i]; }
    ss = red16(ss);
    const float rs = rsqrtf(ss * (1.f / 128.f) + 1e-6f);
    const float* nw = p.dn_norm_w + (c8 & 15) * 8;
#pragma unroll
    for (int i = 0; i < 8; ++i) a[i] = a[i] * rs * nw[i] * siluf_(z[i]);
    *(u32x4*)(on + (size_t)tok * 1536 + c8 * 8) = pack8(a);
    }
  }
}

__device__ __forceinline__ void phase_final_norm(const Params& p) {
  const int gtid = obid() * 512 + otid(), gsz = NBLK * 512, lane = gtid & 63, nw = gsz >> 6;
  for (int r0 = gtid >> 6; r0 < T; r0 += 2 * nw) {
    f32x4 v[2][4]; float ss[2] = {0.f, 0.f};
#pragma unroll
    for (int u = 0; u < 2; ++u) {
      const int r = min(r0 + u * nw, T - 1);
      const f32x4* xr = (const f32x4*)(p.out + (size_t)r * 1024);
#pragma unroll
      for (int i = 0; i < 4; ++i) v[u][i] = xr[i * 64 + lane];
    }
#pragma unroll
    for (int u = 0; u < 2; ++u) {
#pragma unroll
      for (int i = 0; i < 4; ++i) ss[u] += v[u][i][0] * v[u][i][0] + v[u][i][1] * v[u][i][1] + v[u][i][2] * v[u][i][2] + v[u][i][3] * v[u][i][3];
      ss[u] = wave_sum(ss[u]);
    }
#pragma unroll
    for (int u = 0; u < 2; ++u) {
      const int r = r0 + u * nw;
      if (r < T) {
        const float rs = rsqrtf(ss[u] * (1.f / 1024.f) + 1e-6f);
        f32x4* xr = (f32x4*)(p.out + (size_t)r * 1024);
#pragma unroll
        for (int i = 0; i < 4; ++i) { const f32x4 ww = ((const f32x4*)p.final_norm_w)[i * 64 + lane]; xr[i * 64 + lane] = v[u][i] * rs * ww; }
      }
    }
  }
}

__device__ __forceinline__ u32x2 pk4(f32x4 v) { u32x2 o; o.x = pk2(v[0], v[1]); o.y = pk2(v[2], v[3]); return o; }

__device__ __forceinline__ void run_phase(const Params& p, LAS unsigned char* lds, int ph, bool last_rep) {
  unsigned char* ws = p.ws;
  const int bid = obid(), nb = NBLK;
  if (ph == 0) { phase_prep(p); return; }
  if (ph == 1) {
    u16* qkv = (u16*)(ws + O_QKV); u16* pp = (u16*)(ws + O_P); float* gates = (float*)(ws + O_GATES);
    const float* a_log = p.a_log; const float* dtb = p.dt_bias; const float* cw = p.qkv_conv_w;
    auto tep = [=](f32x4 (&acc)[2][2][4][2], int brow, int bcol) {
      const int tid = otid(), wid = tid >> 6, lane = tid & 63, wr = wid >> 2, wc = wid & 3, fr = lane & 15, fq = lane >> 4;
      if (bcol >= 3072) {
#pragma unroll
        for (int ai = 0; ai < 2; ++ai)
#pragma unroll
          for (int m = 0; m < 4; ++m) {
            const int r = ai * HALF + wr * 64 + m * 16 + fr, g = brow + r;
            if (r >= 2 && r < 254 && g < T) {
#pragma unroll
              for (int bj = 0; bj < 2; ++bj)
#pragma unroll
                for (int n = 0; n < 2; ++n) {
                  const int col = bcol + bj * HALF + wc * 32 + n * 16 + fq * 4;
                  const f32x4 v = acc[ai][bj][m][n];
                  if (col < 3584) *(u32x2*)(pp + (size_t)g * 512 + (col - 3072)) = pk4(v);
                  else if (col < 3616) {
                    const int c0 = col - 3584;
                    f32x4 o;
#pragma unroll
                    for (int i = 0; i < 4; ++i) {
                      const int c = c0 + i;
                      if (c < 16) o[i] = sigmoidf_(v[i]);
                      else { const int k = c - 16; const float xx = v[i] + dtb[k]; const float ee = __expf(-fabsf(xx)); const float sp = fmaxf(xx, 0.f) + (ee < 1e-3f ? ee * (1.f - 0.5f * ee) : __logf(1.f + ee)); o[i] = -__expf(a_log[k]) * sp; }
                    }
                    *(f32x4*)(gates + (size_t)g * 32 + c0) = o;
                  }
                }
            }
          }
        return;
      }
#pragma unroll
      for (int ai = 0; ai < 2; ++ai)
#pragma unroll
        for (int m = 0; m < 4; ++m) {
          const int r = ai * HALF + wr * 64 + m * 16 + fr;
#pragma unroll
          for (int bj = 0; bj < 2; ++bj)
#pragma unroll
            for (int n = 0; n < 2; ++n) {
              const int c = (bj * HALF + wc * 32 + n * 16 + fq * 4) >> 2;
              *(LAS u32x2*)(lds + r * 512 + ((c ^ ((r & 15) << 2)) << 3)) = pk4(acc[ai][bj][m][n]);
            }
        }
      __syncthreads();
      const int c8 = lane & 31, rsel = lane >> 5;
      const int ch = bcol + c8 * 8;
      const bool donorm = bcol < 2048;
      const float osc = bcol < 1024 ? 0.08838834764831845f : 1.f;
      float w5[5][8];
#pragma unroll
      for (int t = 0; t < 5; ++t) {
        const f32x4 a = *(const f32x4*)(cw + t * 3072 + ch), bq = *(const f32x4*)(cw + t * 3072 + ch + 4);
        w5[t][0] = a[0]; w5[t][1] = a[1]; w5[t][2] = a[2]; w5[t][3] = a[3]; w5[t][4] = bq[0]; w5[t][5] = bq[1]; w5[t][6] = bq[2]; w5[t][7] = bq[3];
      }
      auto ldrow = [&](int r, float* f) {
        const u32x4 a = *(const LAS u32x4*)(lds + r * 512 + (((2 * c8) ^ ((r & 15) << 2)) << 3));
        unpack8(a, f);
      };
      const int r0 = 2 + wid * 32 + rsel * 16;
      float xw[5][8];
      ldrow(r0 - 2, xw[1]); ldrow(r0 - 1, xw[2]); ldrow(r0, xw[3]); ldrow(min(r0 + 1, 255), xw[4]);
#pragma unroll 2
      for (int k = 0; k < 16; ++k) {
        const int r = r0 + k;
#pragma unroll
        for (int t = 0; t < 4; ++t)
#pragma unroll
          for (int c = 0; c < 8; ++c) xw[t][c] = xw[t + 1][c];
        ldrow(min(r + 2, 255), xw[4]);
        const int g = brow + r, pos = g & (SEQ - 1);
        const bool t0 = pos >= 2, t1 = pos >= 1, t3 = pos < SEQ - 1, t4 = pos < SEQ - 2;
        float y[8], ss = 0.f;
#pragma unroll
        for (int c = 0; c < 8; ++c) {
          float v = w5[2][c] * xw[2][c];
          v += t0 ? w5[0][c] * xw[0][c] : 0.f; v += t1 ? w5[1][c] * xw[1][c] : 0.f;
          v += t3 ? w5[3][c] * xw[3][c] : 0.f; v += t4 ? w5[4][c] * xw[4][c] : 0.f;
          v = siluf_(v); y[c] = v; ss += v * v;
        }
        float sc = 1.f;
        if (donorm) { ss = red16(ss); sc = rsqrtf(ss + 1e-6f) * osc; }
#pragma unroll
        for (int c = 0; c < 8; ++c) y[c] *= sc;
        if (r < 254 && g < T) *(u32x4*)(qkv + (size_t)g * 3072 + ch) = pack8(y);
      }
      __syncthreads();
    };
    gemm_phase<true, false>(lds, (const u16*)(ws + O_HB), 1024, (const u16*)(ws + O_WIN), 1024, T, 3840, 1024, bid, nb,
                     [](int, int) { return (u32x4){0u, 0u, 0u, 0u}; }, [](int, int, f32x4, u32x4) {}, 131, 252, -2, tep);
    return;
  }
  if (ph >= 2 && ph < 2 + 2 * NSTAGE) {
    const int s = (ph - 2) >> 1;
    if ((ph - 2) & 1) phase_scan(p, lds, s, last_rep); else phase_dprep(p, lds, s);
    return;
  }
  const int q = ph - (2 + 2 * NSTAGE);
  if (q == 0) {
    phase_pool_pm(p);
    u16* zg = (u16*)(ws + O_QKV);
    gemm_phase<false, true>(lds, (const u16*)(ws + O_HB), 1024, (const u16*)(ws + O_WIN) + (size_t)3840 * 1024, 1024, T, 3072, 1024, bid, nb,
      [](int, int) { return (u32x4){0u, 0u, 0u, 0u}; }, [=](int row, int col0, f32x4 v0, f32x4 v1) {
      if (col0 >= 1024) {
#pragma unroll
        for (int i = 0; i < 4; ++i) { v0[i] = sigmoidf_(v0[i]); v1[i] = sigmoidf_(v1[i]); }
      }
      u32x4 o; o.x = pk2(v0[0], v0[1]); o.y = pk2(v0[2], v0[3]); o.z = pk2(v1[0], v1[1]); o.w = pk2(v1[2], v1[3]);
      *(u32x4*)(zg + (size_t)row * 3072 + col0) = o; });
    return;
  }
  if (q == 1) { phase_onorm(p); return; }
  if (q == 2) {
    const u16* zg = (const u16*)(ws + O_QKV); u16* mg = (u16*)(ws + O_M);
    auto mid = [=](f32x4 (&acc)[2][2][4][2], int brow, int bcol) {
      const int tid = otid(), wid = tid >> 6, lane = tid & 63, wr = wid >> 2, wc = wid & 3, fr = lane & 15, fq = lane >> 4;
#pragma unroll
      for (int ai = 0; ai < 2; ++ai)
#pragma unroll
        for (int m2 = 0; m2 < 4; m2 += 2) {
          u32x2 gp[2][2][2], gd[2][2][2];
#pragma unroll
          for (int mm = 0; mm < 2; ++mm)
#pragma unroll
            for (int bj = 0; bj < 2; ++bj)
#pragma unroll
              for (int n = 0; n < 2; ++n) {
                const u16* zr = zg + (size_t)(brow + ai * HALF + wr * 64 + (m2 + mm) * 16 + fr) * 3072 + bcol + bj * HALF + wc * 32 + n * 16 + fq * 4;
                gp[mm][bj][n] = *(const u32x2*)(zr + 1024); gd[mm][bj][n] = *(const u32x2*)(zr + 2048);
              }
#pragma unroll
          for (int mm = 0; mm < 2; ++mm)
#pragma unroll
            for (int bj = 0; bj < 2; ++bj)
#pragma unroll
              for (int n = 0; n < 2; ++n) {
                const u32x2 a = gp[mm][bj][n], d = gd[mm][bj][n];
                f32x4& v = acc[ai][bj][m2 + mm][n];
                v[0] *= bflo(a.x) * __builtin_amdgcn_rcpf(fmaxf(bflo(d.x), 1e-30f)); v[1] *= bfhi(a.x) * __builtin_amdgcn_rcpf(fmaxf(bfhi(d.x), 1e-30f));
                v[2] *= bflo(a.y) * __builtin_amdgcn_rcpf(fmaxf(bflo(d.y), 1e-30f)); v[3] *= bfhi(a.y) * __builtin_amdgcn_rcpf(fmaxf(bfhi(d.y), 1e-30f));
              }
        }
    };
    gemm_phase<false, false>(lds, (const u16*)(ws + O_AC), 1536, (const u16*)(ws + O_BC), 1536, T, 1024, 1536, bid, nb,
      [=](int row, int col) { const u32x2 g = *(const u32x2*)(zg + (size_t)row * 3072 + 2048 + col); return (u32x4){g.x, g.y, 0u, 0u}; },
      [=](int row, int col, f32x4 v, u32x4 pv) {
      v[0] *= bflo(pv.x); v[1] *= bfhi(pv.x); v[2] *= bflo(pv.y); v[3] *= bfhi(pv.y);
      *(u32x2*)(mg + (size_t)row * 1024 + col) = pk4(v); }, 0, BM, 0, NoTileEpi(), 8, mid);
    return;
  }
  if (q == 3) {
    const float* x = p.x; u16* x1b = (u16*)(ws + O_HB); float* ssq = (float*)(ws + O_SSQ);
    float ssacc = 0.f;
    gemm_phase(lds, (const u16*)(ws + O_M), 1024, (const u16*)(ws + O_WO), 1024, T, 1024, 1024, bid, nb,
      [=](int row, int col) { return *(const u32x4*)(x + (size_t)row * 1024 + col); },
      [=, &ssacc](int row, int col, f32x4 v, u32x4 pv) {
      const f32x4 r = __builtin_bit_cast(f32x4, pv) + v;
      *(u32x2*)(x1b + (size_t)row * 1024 + col) = pk4(r);
      ssacc += r[0] * r[0] + r[1] * r[1] + r[2] * r[2] + r[3] * r[3]; },
      0, BM, 0, NoTileEpi(), -1, NoMid(),
      [=, &ssacc](int row) {
      float ss = ssacc; ssacc = 0.f;
      ss += __shfl_xor(ss, 16); ss += __shfl_xor(ss, 32);
      if ((otid() & 48) == 0) atomicAdd(ssq + row, ss); });
    return;
  }
  if (q == 4) {
    u16* GV = (u16*)(ws + O_U);
    const float* cw = p.ffn_conv_w; const float* cb = p.ffn_conv_b; const float* ssq = (const float*)(ws + O_SSQ);
    auto tep = [=](f32x4 (&acc)[2][2][4][2], int brow, int bcol) {
      const int tid = otid(), wid = tid >> 6, lane = tid & 63, wr = wid >> 2, wc = wid & 3, fr = lane & 15, fq = lane >> 4;
#pragma unroll
      for (int ai = 0; ai < 2; ++ai)
#pragma unroll
        for (int m = 0; m < 4; ++m) {
          const int r = ai * HALF + wr * 64 + m * 16 + fr;
          const float rs = rsqrtf(ssq[min(max(brow + r, 0), T - 1)] * (1.f / 1024.f) + 1e-6f);
#pragma unroll
          for (int bj = 0; bj < 2; ++bj)
#pragma unroll
            for (int n = 0; n < 2; ++n) {
              const int c = (bj * HALF + wc * 32 + n * 16 + fq * 4) >> 2;
              *(LAS u32x2*)(lds + r * 512 + ((c ^ ((r & 15) << 2)) << 3)) = pk4(acc[ai][bj][m][n] * rs);
            }
        }
      __syncthreads();
      const int c4 = tid & 31, rr = tid >> 5, pn = bcol >> 8;
      const int gch = pn * 128 + c4 * 4, vch = 2816 + gch;
      f32x4 wg[3], wv[3];
#pragma unroll
      for (int t = 0; t < 3; ++t) { wg[t] = *(const f32x4*)(cw + t * 5632 + gch); wv[t] = *(const f32x4*)(cw + t * 5632 + vch); }
      const f32x4 bg = *(const f32x4*)(cb + gch), bv = *(const f32x4*)(cb + vch);
      auto ldrow = [&](int r, f32x4& g, f32x4& v) {
        const int sw = (r & 15) << 2;
        const u32x2 a = *(const LAS u32x2*)(lds + r * 512 + ((c4 ^ sw) << 3));
        const u32x2 b = *(const LAS u32x2*)(lds + r * 512 + (((32 + c4) ^ sw) << 3));
        g = (f32x4){bflo(a.x), bfhi(a.x), bflo(a.y), bfhi(a.y)}; v = (f32x4){bflo(b.x), bfhi(b.x), bflo(b.y), bfhi(b.y)};
      };
      const int r0 = 1 + rr * 16;
      f32x4 gp, vp, gc, vc, gn, vn;
      ldrow(r0 - 1, gp, vp); ldrow(r0, gc, vc);
#pragma unroll
      for (int k = 0; k < 16; ++k) {
        const int r = r0 + k;
        if (r <= 254) {
          ldrow(r + 1, gn, vn);
          const int g = brow + r, pos = g & (SEQ - 1);
          if (g < T) {
            f32x4 ga = bg + wg[1] * gc, va = bv + wv[1] * vc;
            if (pos != 0) { ga += wg[0] * gp; va += wv[0] * vp; }
            if (pos != SEQ - 1) { ga += wg[2] * gn; va += wv[2] * vn; }
            f32x4 o; o[0] = siluf_(ga[0]) * va[0]; o[1] = siluf_(ga[1]) * va[1]; o[2] = siluf_(ga[2]) * va[2]; o[3] = siluf_(ga[3]) * va[3];
            *(u32x2*)(GV + (size_t)g * 2816 + gch) = pk4(o);
          }
          gp = gc; vp = vc; gc = gn; vc = vn;
        }
      }
      __syncthreads();
    };
    gemm_phase<true, false>(lds, (const u16*)(ws + O_HB), 1024, (const u16*)(ws + O_UP), 1024, T, 5632, 1024, bid, nb,
                     [](int, int) { return (u32x4){0u, 0u, 0u, 0u}; }, [](int, int, f32x4, u32x4) {}, 130, 254, -1, tep);
    return;
  }
  if (q == 5) {
    float* out = p.out; const u16* x1b = (const u16*)(ws + O_HB);
    gemm_phase(lds, (const u16*)(ws + O_U), 2816, (const u16*)(ws + O_DN), 2816, T, 1024, 2816, bid, nb,
      [=](int row, int col) { const u32x2 a = *(const u32x2*)(x1b + (size_t)row * 1024 + col); return (u32x4){a.x, a.y, 0u, 0u}; },
      [=](int row, int col, f32x4 v, u32x4 pv) {
        v[0] += bflo(pv.x); v[1] += bfhi(pv.x); v[2] += bflo(pv.y); v[3] += bfhi(pv.y);
        *(f32x4*)(out + (size_t)row * 1024 + col) = v; });
    return;
  }
  if (q == 6) phase_final_norm(p);
}
constexpr int NPHASE = 2 + 2 * NSTAGE + 7;

__global__ void __launch_bounds__(512) mega(Params p) {
  extern __shared__ __attribute__((aligned(16))) unsigned char smem[];
  LAS unsigned char* lds = (LAS unsigned char*)smem;
  cg::grid_group grid = cg::this_grid();
  __shared__ uint4 xb_words;
  if (threadIdx.x == 0) xb_words = make_uint4(0u, 0u, 0u, 0u);
  __syncthreads();
  (void)xcd_barrier_post((unsigned*)(p.ws + O_BAR), (volatile LAS unsigned*)&xb_words);
  for (int ph = p.ph_lo; ph < p.ph_hi; ++ph) {
    const int reps = ((DUP_MASK >> ph) & 1u) ? 2 : 1;
    for (int r = 0; r < reps; ++r) {
      if (ph > p.ph_lo || r > 0) {
        if (ph == NPHASE - 2 && r == 0) grid.sync();
        else { XcdBarrier xb; size_t zb = 0; asm volatile("" : "+s"(zb)); xb.bar = (unsigned*)(p.ws + O_BAR + zb); xb.x = xb_xcc_id(); xb.st = (volatile LAS unsigned*)&xb_words; xcd_barrier(xb); }
      }
      Params q = p;
      size_t zoff = 0;
      asm volatile("" : "+s"(zoff));
      q.ws = p.ws + zoff; q.out = (float*)((unsigned char*)p.out + zoff);
      run_phase(q, lds, ph, r == reps - 1);
    }
  }
}

extern "C" void kernel_launch(void* const* d_in, const int* in_sizes, int n_in, void* d_out, int out_size, void* d_ws, size_t ws_size, hipStream_t stream) {
  static int grid_blocks = 0;
  if (!grid_blocks) {
    if (ws_size < WS_NEED || n_in != 18) { fprintf(stderr, "kernel_launch: need %zu bytes of workspace, got %zu (n_in %d)\n", WS_NEED, ws_size, n_in); grid_blocks = -1; return; }
    int dev = 0, cus = 0, per_cu = 0;
    hipGetDevice(&dev);
    hipDeviceGetAttribute(&cus, hipDeviceAttributeMultiprocessorCount, dev);
    hipFuncSetAttribute((const void*)mega, hipFuncAttributeMaxDynamicSharedMemorySize, LDS_BYTES);
    hipOccupancyMaxActiveBlocksPerMultiprocessor(&per_cu, (const void*)mega, 512, LDS_BYTES);
    if (cus < 256) { fprintf(stderr, "kernel_launch: built for a 256-CU device (got %d)\n", cus); grid_blocks = -1; return; }
    if (per_cu < 1) { fprintf(stderr, "kernel_launch: occupancy query says %d blocks per CU\n", per_cu); grid_blocks = -1; return; }
    grid_blocks = NBLK;
    (void)hipGetLastError();
  }
  if (grid_blocks < 0) return;
  Params p{};
  const float** pp = (const float**)&p;
  for (int i = 0; i < 18; ++i) pp[i] = (const float*)d_in[i];
  p.out = (float*)d_out; p.ws = (unsigned char*)d_ws;
  (void)hipMemsetAsync((unsigned char*)d_ws + O_BAR, 0, XCD_BAR_WORDS * 4, stream);
#if N_LAUNCH_MODE == 1
  p.ph_lo = 0; p.ph_hi = NPHASE;
  void* args[] = {&p};
  hipError_t e = hipLaunchCooperativeKernel((const void*)mega, dim3(grid_blocks), dim3(512), args, LDS_BYTES, stream);
  if (e != hipSuccess) fprintf(stderr, "cooperative launch failed: %s (grid %d)\n", hipGetErrorString(e), grid_blocks);
#else
  for (int ph = 0; ph < NPHASE; ++ph) {
    p.ph_lo = ph; p.ph_hi = ph + 1;
    hipLaunchKernelGGL(mega, dim3(grid_blocks), dim3(512), LDS_BYTES, stream, p);
  }
#endif
}
```
